# Optimizing an MI355X kernel written in HIP

```python
import math
import jax, jax.numpy as jnp
from jax import lax
import numpy as np

D_MODEL = 2048
BATCH = 4
SEQ = 4096
DEPTH = 2

CHUNK = 64
D_MIX = D_MODEL
A_HEADS = 8
A_HEAD_DIM = D_MODEL // 16
A_WIDTH = A_HEADS * A_HEAD_DIM
CONV_WIDTH = 4
B_HEADS = 8
B_KV_HEADS = 2
B_HEAD_DIM = D_MODEL // 32
B_WIDTH = B_HEADS * B_HEAD_DIM
B_KV_DIM = B_KV_HEADS * B_HEAD_DIM
WINDOW = 128
WINDOW_CHUNKS = WINDOW // CHUNK
C_WIDTH = D_MIX - A_WIDTH - B_WIDTH
S5_GROUP = 16
S5_GROUPS = C_WIDTH // S5_GROUP
S5_STATE = 64
D_IN = 3 * A_WIDTH + A_WIDTH + 2 * A_HEADS + B_WIDTH + 2 * B_KV_DIM + C_WIDTH
D_FF = 7 * D_MODEL // 2
N_EXPERTS = 8
TOP_K = 2
EPS = 1e-6

kernel_name = "hybrid_parallel_deltanet_swa_s5_moe"


def _split_points():
    sizes = (3 * A_WIDTH, A_WIDTH, A_HEADS, A_HEADS, B_WIDTH, B_KV_DIM, B_KV_DIM, C_WIDTH)
    pts, acc = [], 0
    for s in sizes[:-1]:
        acc += s
        pts.append(acc)
    return pts


def rms_norm(x, gain):
    xf = x.astype(jnp.float32)
    y = xf * lax.rsqrt(jnp.mean(xf * xf, axis=-1, keepdims=True) + EPS)
    return (y * gain.astype(jnp.float32)).astype(x.dtype)


def l2_norm(x):
    return x * lax.rsqrt(jnp.sum(x * x, axis=-1, keepdims=True) + EPS)


def causal_depthwise_conv(x, w):
    k_taps = w.shape[0]
    l = x.shape[1]
    xp = jnp.pad(x, ((0, 0), (k_taps - 1, 0), (0, 0)))
    y = xp[:, 0:l] * w[0]
    for j in range(1, k_taps):
        y = y + xp[:, j:j + l] * w[j]
    return y


def gated_delta_rule(q, k, v, g, beta):
    b, l, h, dk = q.shape
    dv = v.shape[-1]
    nc = l // CHUNK

    def to_chunks(t):
        t = t.reshape((b, nc, CHUNK, h) + t.shape[3:])
        return jnp.moveaxis(t, 3, 1)

    q, k, v, g, beta = (to_chunks(t) for t in (q, k, v, g, beta))
    gc = jnp.cumsum(g, axis=-1)
    idx = jnp.arange(CHUNK)
    incl = idx[:, None] >= idx[None, :]
    strict = idx[:, None] > idx[None, :]
    gdiff = gc[..., :, None] - gc[..., None, :]
    decay_incl = jnp.exp(jnp.where(incl, gdiff, -jnp.inf))
    decay_strict = jnp.where(strict, decay_incl, 0.0)
    kb = k * beta[..., None]
    lower = jnp.einsum('bhnid,bhnjd->bhnij', kb, k) * decay_strict
    eye = jnp.eye(CHUNK, dtype=q.dtype)
    rhs = jnp.concatenate([v * beta[..., None], kb * jnp.exp(gc)[..., None]], axis=-1)
    sol = lax.linalg.triangular_solve(lower + eye, rhs, left_side=True, lower=True, unit_diagonal=True)
    u, w = sol[..., :dv], sol[..., dv:]
    attn = jnp.einsum('bhnid,bhnjd->bhnij', q, k) * decay_incl
    g_last = gc[..., -1]
    q_dec = q * jnp.exp(gc)[..., None]
    k_dec = k * jnp.exp(g_last[..., None] - gc)[..., None]
    xs = tuple(jnp.moveaxis(t, 2, 0) for t in (q_dec, k_dec, u, w, attn, g_last))

    def step(state, inp):
        qd, kd, uc, wc, ac, gl = inp
        v_new = uc - jnp.einsum('bhcd,bhde->bhce', wc, state)
        o = jnp.einsum('bhcd,bhde->bhce', qd, state) + jnp.einsum('bhij,bhje->bhie', ac, v_new)
        state = state * jnp.exp(gl)[..., None, None] + jnp.einsum('bhcd,bhce->bhde', kd, v_new)
        return state, o

    s0 = jnp.zeros((b, h, dk, dv), q.dtype)
    _, o = lax.scan(step, s0, xs)
    o = jnp.transpose(o, (1, 0, 3, 2, 4))
    return o.reshape(b, l, h, dv)


def mixer_deltanet(qkv, gate, a_logit, b_logit, conv_w, a_log, dt_bias, norm_gain):
    b, l, _ = qkv.shape
    f32 = jnp.float32
    qkv = jax.nn.silu(causal_depthwise_conv(qkv, conv_w))
    q, k, v = jnp.split(qkv, 3, axis=-1)
    shp = (b, l, A_HEADS, A_HEAD_DIM)
    q = l2_norm(q.reshape(shp).astype(f32)) * (A_HEAD_DIM ** -0.5)
    k = l2_norm(k.reshape(shp).astype(f32))
    v = v.reshape(shp).astype(f32)
    g = -jnp.exp(a_log.astype(f32)) * jax.nn.softplus(a_logit.astype(f32) + dt_bias.astype(f32))
    beta = jax.nn.sigmoid(b_logit.astype(f32))
    o = gated_delta_rule(q, k, v, g, beta)
    o = rms_norm(o, norm_gain) * jax.nn.silu(gate.reshape(shp).astype(f32))
    return o.reshape(b, l, A_WIDTH).astype(qkv.dtype)


def mixer_window_attention(q, k, v, sinks):
    b, l, _ = q.shape
    nc = l // CHUNK
    grp = B_HEADS // B_KV_HEADS
    band_len = (WINDOW_CHUNKS + 1) * CHUNK
    q = q.reshape(b, nc, CHUNK, B_KV_HEADS, grp, B_HEAD_DIM)

    def band(t):
        t = t.reshape(b, nc, CHUNK, B_KV_HEADS, B_HEAD_DIM)
        t = jnp.pad(t, ((0, 0), (WINDOW_CHUNKS, 0), (0, 0), (0, 0), (0, 0)))
        return jnp.concatenate([t[:, o:o + nc] for o in range(WINDOW_CHUNKS + 1)], axis=2)

    kb, vb = band(k), band(v)
    s = jnp.einsum('bnqkgd,bnskd->bnkgqs', q, kb).astype(jnp.float32) * (B_HEAD_DIM ** -0.5)
    src_chunk = jnp.arange(nc)[:, None] - WINDOW_CHUNKS + (jnp.arange(band_len) // CHUNK)[None, :]
    valid = src_chunk >= 0
    s = jnp.where(valid[None, :, None, None, None, :], s, -jnp.inf)
    sink = sinks.astype(jnp.float32).reshape(B_KV_HEADS, grp)[None, None, :, :, None, None]
    m = jnp.maximum(jnp.max(s, axis=-1, keepdims=True), sink)
    p = jnp.exp(s - m)
    denom = jnp.sum(p, axis=-1, keepdims=True) + jnp.exp(sink - m)
    o = jnp.einsum('bnkgqs,bnskd->bnqkgd', (p / denom).astype(vb.dtype), vb)
    return o.reshape(b, l, B_WIDTH)


def _complex_affine_combine(e1, e2):
    a1r, a1i, b1r, b1i = e1
    a2r, a2i, b2r, b2i = e2
    ar = a2r * a1r - a2i * a1i
    ai = a2r * a1i + a2i * a1r
    br = a2r * b1r - a2i * b1i + b2r
    bi = a2r * b1i + a2i * b1r + b2i
    return (ar, ai, br, bi)


def mixer_s5(u, lam_re, lam_im, log_dt, s5_b_re, s5_b_im, s5_c_re, s5_c_im, s5_d, w_glu, b_glu):
    f32 = jnp.float32
    bsz, l, _ = u.shape
    uf = u.astype(f32).reshape(bsz, l, S5_GROUPS, S5_GROUP)
    dt = jnp.exp(log_dt.astype(f32))[:, None]
    lr = jnp.minimum(lam_re.astype(f32), -1e-4)
    li = lam_im.astype(f32)
    mag = jnp.exp(lr * dt)
    ab_re = mag * jnp.cos(li * dt)
    ab_im = mag * jnp.sin(li * dt)
    den = lr * lr + li * li
    nr = ab_re - 1.0
    coef_re = (nr * lr + ab_im * li) / den
    coef_im = (ab_im * lr - nr * li) / den
    br, bi = s5_b_re.astype(f32), s5_b_im.astype(f32)
    bb_re = coef_re[..., None] * br - coef_im[..., None] * bi
    bb_im = coef_re[..., None] * bi + coef_im[..., None] * br
    bu_re = jnp.einsum('blgh,gph->blgp', uf, bb_re)
    bu_im = jnp.einsum('blgh,gph->blgp', uf, bb_im)
    a_re = jnp.broadcast_to(ab_re, bu_re.shape)
    a_im = jnp.broadcast_to(ab_im, bu_im.shape)
    _, _, x_re, x_im = lax.associative_scan(_complex_affine_combine, (a_re, a_im, bu_re, bu_im), axis=1)
    y = (jnp.einsum('blgp,ghp->blgh', x_re, s5_c_re.astype(f32))
         - jnp.einsum('blgp,ghp->blgh', x_im, s5_c_im.astype(f32))
         + s5_d.astype(f32) * uf)
    y = y.reshape(bsz, l, C_WIDTH)
    z = jax.nn.gelu(y)
    out = z * jax.nn.sigmoid(z @ w_glu.astype(f32) + b_glu.astype(f32))
    return out.astype(u.dtype)


def hybrid_mixer(h, w_in, conv_w, a_log, dt_bias, a_norm, sinks, b_norm,
                 lam_re, lam_im, log_dt, s5_b_re, s5_b_im, s5_c_re, s5_c_im, s5_d,
                 w_glu, b_glu, c_norm, w_out):
    proj = h @ w_in
    a_qkv, a_gate, a_alpha, a_beta, b_q, b_k, b_v, c_u = jnp.split(proj, _split_points(), axis=-1)
    ya = mixer_deltanet(a_qkv, a_gate, a_alpha, a_beta, conv_w, a_log, dt_bias, a_norm)
    yb = rms_norm(mixer_window_attention(b_q, b_k, b_v, sinks), b_norm)
    yc = rms_norm(mixer_s5(c_u, lam_re, lam_im, log_dt, s5_b_re, s5_b_im, s5_c_re, s5_c_im,
                           s5_d, w_glu, b_glu), c_norm)
    return jnp.concatenate([ya, yb, yc], axis=-1) @ w_out


def swiglu(x, wg, wu, wd):
    return (jax.nn.silu(x @ wg) * (x @ wu)) @ wd


def moe_swiglu(x, w_router, wg, wu, wd):
    b, l, d = x.shape
    xt = x.reshape(b * l, d)
    logits = (xt @ w_router).astype(jnp.float32)
    top_vals, top_idx = lax.top_k(logits, TOP_K)
    gates = jax.nn.softmax(top_vals, axis=-1)
    combine = jnp.sum(jax.nn.one_hot(top_idx, N_EXPERTS, dtype=jnp.float32) * gates[..., None], axis=1)
    y = jnp.zeros_like(xt)
    for e in range(N_EXPERTS):
        y = y + combine[:, e:e + 1].astype(xt.dtype) * swiglu(xt, wg[e], wu[e], wd[e])
    return y.reshape(b, l, d)


def setup_inputs(seed: int = 0) -> dict:
    key = jax.random.key(seed)
    ks = iter(jax.random.split(key, 40))
    nrm = lambda shape, scale: jax.random.normal(next(ks), shape, jnp.float32) * scale
    n_dense = (DEPTH + 1) // 2
    n_moe = DEPTH // 2
    dt_a = jnp.exp(jax.random.uniform(next(ks), (DEPTH, A_HEADS), jnp.float32, math.log(1e-3), math.log(1e-1)))
    lam_im_base = math.pi * jnp.arange(S5_STATE, dtype=jnp.float32)
    return {
        "x": nrm((BATCH, SEQ, D_MODEL), 1.0),
        "ln_gains": 1.0 + nrm((DEPTH, 4, D_MODEL), 0.01),
        "w_in": nrm((DEPTH, D_MODEL, D_IN), D_MODEL ** -0.5),
        "conv_w": nrm((DEPTH, CONV_WIDTH, 3 * A_WIDTH), CONV_WIDTH ** -0.5),
        "a_log": jnp.log(jax.random.uniform(next(ks), (DEPTH, A_HEADS), jnp.float32, 1.0, 16.0)),
        "dt_bias": dt_a + jnp.log(-jnp.expm1(-dt_a)),
        "a_norm": 1.0 + nrm((DEPTH, A_HEAD_DIM), 0.01),
        "sinks": nrm((DEPTH, B_HEADS), 1.0),
        "b_norm": 1.0 + nrm((DEPTH, B_WIDTH), 0.01),
        "lam_re": -0.5 + nrm((DEPTH, S5_GROUPS, S5_STATE), 0.01),
        "lam_im": lam_im_base + nrm((DEPTH, S5_GROUPS, S5_STATE), 0.01),
        "log_dt": jax.random.uniform(next(ks), (DEPTH, S5_GROUPS), jnp.float32, math.log(1e-3), math.log(1e-1)),
        "s5_b_re": nrm((DEPTH, S5_GROUPS, S5_STATE, S5_GROUP), (2 * S5_GROUP) ** -0.5),
        "s5_b_im": nrm((DEPTH, S5_GROUPS, S5_STATE, S5_GROUP), (2 * S5_GROUP) ** -0.5),
        "s5_c_re": nrm((DEPTH, S5_GROUPS, S5_GROUP, S5_STATE), (2 * S5_STATE) ** -0.5),
        "s5_c_im": nrm((DEPTH, S5_GROUPS, S5_GROUP, S5_STATE), (2 * S5_STATE) ** -0.5),
        "s5_d": nrm((DEPTH, S5_GROUPS, S5_GROUP), 1.0),
        "w_glu": nrm((DEPTH, C_WIDTH, C_WIDTH), C_WIDTH ** -0.5),
        "b_glu": nrm((DEPTH, C_WIDTH), 0.01),
        "c_norm": 1.0 + nrm((DEPTH, C_WIDTH), 0.01),
        "w_out": nrm((DEPTH, D_MIX, D_MODEL), D_MIX ** -0.5),
        "ffn_wg": nrm((n_dense, D_MODEL, D_FF), D_MODEL ** -0.5),
        "ffn_wu": nrm((n_dense, D_MODEL, D_FF), D_MODEL ** -0.5),
        "ffn_wd": nrm((n_dense, D_FF, D_MODEL), D_FF ** -0.5),
        "w_router": nrm((n_moe, D_MODEL, N_EXPERTS), D_MODEL ** -0.5),
        "moe_wg": nrm((n_moe, N_EXPERTS, D_MODEL, D_FF), D_MODEL ** -0.5),
        "moe_wu": nrm((n_moe, N_EXPERTS, D_MODEL, D_FF), D_MODEL ** -0.5),
        "moe_wd": nrm((n_moe, N_EXPERTS, D_FF, D_MODEL), D_FF ** -0.5),
    }


def reference(x, ln_gains, w_in, conv_w, a_log, dt_bias, a_norm, sinks, b_norm,
              lam_re, lam_im, log_dt, s5_b_re, s5_b_im, s5_c_re, s5_c_im, s5_d,
              w_glu, b_glu, c_norm, w_out, ffn_wg, ffn_wu, ffn_wd,
              w_router, moe_wg, moe_wu, moe_wd):
    for i in range(DEPTH):
        g = ln_gains[i]
        mix = hybrid_mixer(rms_norm(x, g[0]), w_in[i], conv_w[i], a_log[i], dt_bias[i], a_norm[i],
                           sinks[i], b_norm[i], lam_re[i], lam_im[i], log_dt[i], s5_b_re[i],
                           s5_b_im[i], s5_c_re[i], s5_c_im[i], s5_d[i], w_glu[i], b_glu[i],
                           c_norm[i], w_out[i])
        x = x + rms_norm(mix, g[1])
        hn = rms_norm(x, g[2])
        j = i // 2
        if i % 2 == 0:
            f = swiglu(hn, ffn_wg[j], ffn_wu[j], ffn_wd[j])
        else:
            f = moe_swiglu(hn, w_router[j], moe_wg[j], moe_wu[j], moe_wd[j])
        x = x + rms_norm(f, g[3])
    return x
```

```cpp
#include <hip/hip_runtime.h>
#include <cstdio>
#include <cstdint>
#define MULTI_LAUNCH 0
#define NAIVE_DN 0
#define NAIVE_SWA 0
#define NAIVE_S5 0
namespace pg8 {
#define PG8_LAS __attribute__((address_space(3)))
typedef unsigned short bf16_t;
typedef short bf16x8 __attribute__((ext_vector_type(8)));
typedef float f32x4 __attribute__((ext_vector_type(4)));
typedef unsigned u32x4 __attribute__((ext_vector_type(4)));
constexpr int BM = 256, BK = 64, HALF = 128, HTB = HALF * BK * 2  , STAGE_BYTES = 8 * HTB, NXCD = 8, WGM = 4;

__host__ __device__ __forceinline__ int lds_byte(int r, int c) { const int st = (r >> 4) * 2 + (c >> 5), rr = r & 15, cc = c & 31, ob = rr * 64 + cc * 2; return st * 1024 + (ob ^ (((ob >> 9) & 1) << 5)); }
__host__ __device__ __forceinline__ void stage_rc(int b, int& R, int& C) { const int st = b / 1024, sb = b % 1024, swz = sb ^ (((sb >> 9) & 1) << 5); R = (st >> 1) * 16 + swz / 64; C = (st & 1) * 32 + (swz % 64) / 2; }
__host__ __device__ __forceinline__ int perm32(int rho) { const int n = rho >> 4, i = rho & 15; return 8 * (i >> 2) + 4 * n + (i & 3); }

struct Unit { int pm, pn, pb, ks; };
struct Gemm { const bf16_t* A; const bf16_t* Bt; int M, N, K; };

struct StaticOrder {
    static constexpr bool SPLITK = false; static constexpr int NSPLIT = 1;
    int nM, nN, nwg, G, c;
    __host__ __device__ void init(int M, int N, int G_, int c_) { nM = M / BM; nN = N / BM; nwg = nM * nN; G = G_; c = c_; }
    __host__ __device__ bool next(int i, Unit& u) const {
        const long L = (long)i * G + c; if (L >= nwg) return false;
        int wgid = (int)L; { const int q = nwg / NXCD, r = nwg % NXCD, xcd = wgid % NXCD, off = wgid / NXCD; wgid = (xcd < r ? xcd * (q + 1) : r * (q + 1) + (xcd - r) * q) + off; }
        const int nig = WGM * nN, gid = wgid / nig, fm = gid * WGM, gsz = (nM - fm) < WGM ? (nM - fm) : WGM;
        u.pm = fm + ((wgid % nig) % gsz); u.pn = (wgid % nig) / gsz; u.pb = u.pn; return true;
    }
    __device__ __forceinline__ void a_ready(const Unit&) const {}
    __device__ __forceinline__ void done(const Unit&) const {}
};

__device__ __forceinline__ unsigned cvt_pk_bf16(float lo, float hi) { unsigned r; asm volatile("v_cvt_pk_bf16_f32 %0, %1, %2" : "=v"(r) : "v"(lo), "v"(hi)); return r; }
typedef float f32x2 __attribute__((ext_vector_type(2)));
template <class Epi, class Sched, bool ALIGN_EPI = false, bool SP2 = false, bool FP8 = false, bool I8 = false>
__device__ __forceinline__ void gemm_phase(PG8_LAS unsigned char* lds, const Gemm g, const Sched& S, const Epi& E) {
    int tid_ = threadIdx.x; asm volatile("" : "+v"(tid_));
    const int tid = tid_, wid = __builtin_amdgcn_readfirstlane(tid >> 6), lane = tid & 63, wr = wid >> 2, wc = wid & 3, fr = lane & 15, fq = lane >> 4;
    const int K = g.K, nt = K / BK;
    unsigned voffA[2], voffB[2];
#pragma unroll
    for (int i = 0; i < 2; ++i) { int R, C; stage_rc(tid * 16 + i * 8192, R, C); const int Rb = Epi::PERM ? ((R & ~31) + perm32(R & 31)) : R;
        voffA[i] = (unsigned)(R * K + C) * 2u; voffB[i] = (unsigned)(Rb * K + C) * 2u; }
    const size_t kstep = (size_t)(BK * 2);
    const size_t hstep = (size_t)HALF * K * 2;
    const size_t tstep = 2 * hstep;
    const unsigned ldsw = (unsigned)wid * 1024u;
    const int aoff = lds_byte(wr * 64 + fr, fq * 8), boff = lds_byte(wc * 32 + fr, fq * 8);
    const size_t sdelta = (size_t)64 * K * 2;
    PG8_LAS unsigned char* ldsB = lds + 4 * HTB + boff; asm volatile("" : "+v"(ldsB));
#define PG8_SA(b, h) (((b) * 2 + (h)) * HTB)
#define PG8_SB(b, h) ((4 + (b) * 2 + (h)) * HTB)
#define PG8_STAGE(bufoff, gbase, voff) do { _Pragma("unroll") for (int _i = 0; _i < 2; ++_i) \
        __builtin_amdgcn_global_load_lds((const unsigned*)((const char*)(gbase) + (size_t)_i * sdelta + (voff)[0]), (PG8_LAS unsigned*)(lds + (bufoff) + ldsw + _i * 8192), 16, 0, 0); } while (0)
#define PG8_LDA(dst, b, h) do { _Pragma("unroll") for (int m = 0; m < 4; ++m) _Pragma("unroll") for (int k = 0; k < 2; ++k) dst[m][k] = *(const PG8_LAS bf16x8*)(lds + PG8_SA(b, h) + aoff + m * 2048 + k * 1024); } while (0)
#define PG8_LDB(dst, b, h) do { _Pragma("unroll") for (int n = 0; n < 2; ++n) _Pragma("unroll") for (int k = 0; k < 2; ++k) dst[n][k] = *(const PG8_LAS bf16x8*)(ldsB + ((b) * 2 + (h)) * HTB + n * 2048 + k * 1024); } while (0)
#define PG8_MMA(ai, bj, At, Bt) do { __builtin_amdgcn_s_setprio(1); _Pragma("unroll") for (int m = 0; m < 4; ++m) _Pragma("unroll") for (int n = 0; n < 2; ++n) { \
        if constexpr (FP8) { typedef int i32x8_ __attribute__((ext_vector_type(8))); typedef int i32x4_ __attribute__((ext_vector_type(4))); \
            const i32x4_ a0_ = __builtin_bit_cast(i32x4_, At[m][0]), a1_ = __builtin_bit_cast(i32x4_, At[m][1]), b0_ = __builtin_bit_cast(i32x4_, Bt[n][0]), b1_ = __builtin_bit_cast(i32x4_, Bt[n][1]); \
            const i32x8_ a8_ = __builtin_shufflevector(a0_, a1_, 0, 1, 2, 3, 4, 5, 6, 7), b8_ = __builtin_shufflevector(b0_, b1_, 0, 1, 2, 3, 4, 5, 6, 7); \
            asm("v_mfma_f32_16x16x128_f8f6f4 %0, %1, %2, %0" : "+v"(acc[ai][bj][m][n]) : "v"(b8_), "v"(a8_)); }   \
        else if constexpr (I8) { typedef int i32x4_ __attribute__((ext_vector_type(4))); \
            _Pragma("unroll") for (int k = 0; k < 2; ++k) acc[ai][bj][m][n] = __builtin_bit_cast(f32x4, __builtin_amdgcn_mfma_i32_16x16x64_i8(__builtin_bit_cast(i32x4_, Bt[n][k]), __builtin_bit_cast(i32x4_, At[m][k]), __builtin_bit_cast(i32x4_, acc[ai][bj][m][n]), 0, 0, 0)); } \
        else { _Pragma("unroll") for (int k = 0; k < 2; ++k) acc[ai][bj][m][n] = __builtin_amdgcn_mfma_f32_16x16x32_bf16(Bt[n][k], At[m][k], acc[ai][bj][m][n], 0, 0, 0); } } \
        __builtin_amdgcn_s_setprio(0); } while (0)
#define PG8_WAIT_V(n) asm volatile("s_waitcnt vmcnt(" #n ")" ::: "memory")
#define PG8_WAIT_L(n) asm volatile("s_waitcnt lgkmcnt(" #n ")" ::: "memory")
#define PG8_BAR __builtin_amdgcn_s_barrier()
#define PG8_SCHED __builtin_amdgcn_sched_barrier(0)
    Unit cur, nxt; int ui = 0;
    if (!S.next(0, cur)) return;
    f32x4 acc[2][2][4][2];
#pragma unroll
    for (int a = 0; a < 2; ++a)
#pragma unroll
        for (int b = 0; b < 2; ++b)
#pragma unroll
            for (int m = 0; m < 4; ++m)
#pragma unroll
                for (int n = 0; n < 2; ++n) acc[a][b][m][n] = (f32x4){0.f, 0.f, 0.f, 0.f};
    bf16x8 At[4][2], B0[2][2], B1[2][2];
    const char* cA = (const char*)g.A + (size_t)cur.pm * tstep; const char* cB = (const char*)g.Bt + (size_t)cur.pb * tstep;
    int ntu = nt;
    if constexpr (Sched::SPLITK) { if (cur.ks >= 0) { ntu = nt / Sched::NSPLIT; const size_t ko = (size_t)cur.ks * (size_t)ntu * kstep; cA += ko; cB += ko; } }
    S.a_ready(cur);
    if constexpr (SP2) {
        PG8_STAGE(PG8_SB(0, 0), cB, voffB); PG8_STAGE(PG8_SB(0, 1), cB + hstep, voffB); PG8_STAGE(PG8_SA(0, 0), cA, voffA); PG8_STAGE(PG8_SA(0, 1), cA + hstep, voffA);
        if (wr == 1) PG8_BAR;
        PG8_WAIT_V(2); PG8_BAR;
        PG8_STAGE(PG8_SB(1, 0), cB + kstep, voffB); PG8_STAGE(PG8_SA(1, 0), cA + kstep, voffA); PG8_STAGE(PG8_SB(1, 1), cB + hstep + kstep, voffB);
        PG8_WAIT_V(6); PG8_BAR;
    } else {
        PG8_STAGE(PG8_SB(0, 0), cB, voffB); PG8_STAGE(PG8_SA(0, 0), cA, voffA); PG8_STAGE(PG8_SB(0, 1), cB + hstep, voffB); PG8_STAGE(PG8_SA(0, 1), cA + hstep, voffA);
        if (wr == 1) PG8_BAR;
        PG8_WAIT_V(4); PG8_BAR;
        PG8_STAGE(PG8_SB(1, 0), cB + kstep, voffB); PG8_STAGE(PG8_SA(1, 0), cA + kstep, voffA); PG8_STAGE(PG8_SB(1, 1), cB + hstep + kstep, voffB);
        PG8_WAIT_V(6); PG8_BAR;
    }
    for (;;) {
        const bool has_next = S.next(ui + 1, nxt);
        const char* nA = has_next ? (const char*)g.A + (size_t)nxt.pm * tstep : cA; const char* nB = has_next ? (const char*)g.Bt + (size_t)nxt.pb * tstep : cB;
        if constexpr (Sched::SPLITK) { if (has_next && nxt.ks >= 0) { const size_t ko = (size_t)nxt.ks * (size_t)(nt / Sched::NSPLIT) * kstep; nA += ko; nB += ko; } }
        for (int t = 0; t < ntu; t += 2) {
            const bool last = (t == ntu - 2);
            const char* a1 = cA + (size_t)(t + 1) * kstep;
            const char* a2 = last ? nA : cA + (size_t)(t + 2) * kstep; const char* b2 = last ? nB : cB + (size_t)(t + 2) * kstep;
            const char* a3 = a2 + kstep; const char* b3 = b2 + kstep;
            if (last && has_next) S.a_ready(nxt);
            if constexpr (SP2) {
            PG8_LDB(B0, 0, 0); PG8_LDB(B1, 0, 1); PG8_SCHED; PG8_LDA(At, 0, 0); PG8_STAGE(PG8_SA(1, 1), a1 + hstep, voffA);
            PG8_WAIT_V(8); PG8_WAIT_L(0); PG8_BAR; PG8_MMA(0, 0, At, B0); PG8_MMA(0, 1, At, B1); PG8_BAR; PG8_SCHED;
            PG8_LDA(At, 0, 1); PG8_STAGE(PG8_SB(0, 0), b2, voffB); PG8_STAGE(PG8_SB(0, 1), b2 + hstep, voffB); PG8_STAGE(PG8_SA(0, 0), a2, voffA);
            PG8_WAIT_V(8); PG8_WAIT_L(0); PG8_BAR; PG8_MMA(1, 0, At, B0); PG8_MMA(1, 1, At, B1); PG8_BAR; PG8_SCHED;
            PG8_LDB(B0, 1, 0); PG8_LDB(B1, 1, 1); PG8_SCHED; PG8_LDA(At, 1, 0); PG8_STAGE(PG8_SA(0, 1), a2 + hstep, voffA);
            PG8_WAIT_V(8); PG8_WAIT_L(0); PG8_BAR; PG8_MMA(0, 0, At, B0); PG8_MMA(0, 1, At, B1); PG8_BAR; PG8_SCHED;
            PG8_LDA(At, 1, 1); PG8_STAGE(PG8_SB(1, 0), b3, voffB); PG8_STAGE(PG8_SB(1, 1), b3 + hstep, voffB); PG8_STAGE(PG8_SA(1, 0), a3, voffA);
            PG8_WAIT_V(8); PG8_WAIT_L(0); PG8_BAR; PG8_MMA(1, 0, At, B0); PG8_MMA(1, 1, At, B1); PG8_BAR; PG8_SCHED;
            } else {
            PG8_LDB(B0, 0, 0); PG8_SCHED; PG8_LDA(At, 0, 0); PG8_STAGE(PG8_SA(1, 1), a1 + hstep, voffA);
            PG8_WAIT_L(8); PG8_BAR; PG8_WAIT_L(0); PG8_MMA(0, 0, At, B0); PG8_BAR; PG8_SCHED;
            PG8_LDB(B1, 0, 1); PG8_STAGE(PG8_SB(0, 0), b2, voffB);
            PG8_BAR; PG8_WAIT_L(0); PG8_MMA(0, 1, At, B1); PG8_BAR;
            PG8_LDA(At, 0, 1); PG8_STAGE(PG8_SA(0, 0), a2, voffA);
            PG8_BAR; PG8_WAIT_L(0); PG8_MMA(1, 0, At, B0); PG8_BAR; PG8_SCHED;
            PG8_STAGE(PG8_SB(0, 1), b2 + hstep, voffB);
            PG8_WAIT_V(6); PG8_BAR; PG8_MMA(1, 1, At, B1); PG8_BAR;
            PG8_LDB(B0, 1, 0); PG8_SCHED; PG8_LDA(At, 1, 0); PG8_STAGE(PG8_SA(0, 1), a2 + hstep, voffA);
            PG8_WAIT_L(8); PG8_BAR; PG8_WAIT_L(0); PG8_MMA(0, 0, At, B0); PG8_BAR; PG8_SCHED;
            PG8_LDB(B1, 1, 1); PG8_STAGE(PG8_SB(1, 0), b3, voffB);
            PG8_BAR; PG8_WAIT_L(0); PG8_MMA(0, 1, At, B1); PG8_BAR;
            PG8_LDA(At, 1, 1); PG8_STAGE(PG8_SA(1, 0), a3, voffA);
            PG8_BAR; PG8_WAIT_L(0); PG8_MMA(1, 0, At, B0); PG8_BAR; PG8_SCHED;
            PG8_STAGE(PG8_SB(1, 1), b3 + hstep, voffB);
            PG8_WAIT_V(6); PG8_BAR; PG8_MMA(1, 1, At, B1); PG8_BAR;
            }
        }
        if constexpr (ALIGN_EPI) { if (wr == 0) PG8_BAR; }
        if constexpr (FP8) asm volatile("s_nop 15\n\ts_nop 15" ::: "memory");
        if constexpr (!Epi::AFTER_DRAIN) { E(acc, cur, wr, wc, fr, fq); S.done(cur); }
        if (!has_next) break;
#pragma unroll
        for (int a = 0; a < 2; ++a)
#pragma unroll
            for (int b = 0; b < 2; ++b)
#pragma unroll
                for (int m = 0; m < 4; ++m)
#pragma unroll
                    for (int n = 0; n < 2; ++n) acc[a][b][m][n] = (f32x4){0.f, 0.f, 0.f, 0.f};
        cur = nxt; cA = nA; cB = nB; ++ui;
        if constexpr (Sched::SPLITK) ntu = cur.ks >= 0 ? nt / Sched::NSPLIT : nt;
        if constexpr (ALIGN_EPI) { if (wr == 1) PG8_BAR; }
    }
    PG8_WAIT_V(0);
    if constexpr (!ALIGN_EPI) { if (wr == 0) PG8_BAR; }
    PG8_BAR;
    if constexpr (Epi::AFTER_DRAIN) { E.fused(acc, cur, wr, wc, fr, fq, lds, wid, lane); S.done(cur); }
#undef PG8_SA
#undef PG8_SB
#undef PG8_STAGE
#undef PG8_LDA
#undef PG8_LDB
#undef PG8_MMA
#undef PG8_WAIT_V
#undef PG8_WAIT_L
#undef PG8_BAR
#undef PG8_SCHED
}
}
namespace pg8 {
__device__ __forceinline__ float fast_sigmoid(float x) { return __builtin_amdgcn_rcpf(1.0f + __expf(-x)); }
struct EpiStore {
    static constexpr bool PERM = true, AFTER_DRAIN = false;
    bf16_t* O; int ldc;
    __device__ __forceinline__ void operator()(const f32x4 (&acc)[2][2][4][2], const Unit& u, int wr, int wc, int fr, int fq) const {
        const int row0 = u.pm * BM + wr * 64 + fr, col0 = u.pn * BM + wc * 32 + 8 * fq;
#pragma unroll
        for (int ai = 0; ai < 2; ++ai)
#pragma unroll
            for (int m = 0; m < 4; ++m) { bf16_t* rowp = O + (size_t)(row0 + ai * HALF + m * 16) * ldc + col0;
#pragma unroll
                for (int bj = 0; bj < 2; ++bj) { const f32x4 v0 = acc[ai][bj][m][0], v1 = acc[ai][bj][m][1];
                    u32x4 w; w.x = cvt_pk_bf16(v0[0], v0[1]); w.y = cvt_pk_bf16(v0[2], v0[3]); w.z = cvt_pk_bf16(v1[0], v1[1]); w.w = cvt_pk_bf16(v1[2], v1[3]);
                    *(u32x4*)(rowp + bj * HALF) = w; } }
    }
};
struct EpiSwiGLU {
    static constexpr bool PERM = true, AFTER_DRAIN = false;
    bf16_t* O; int ldc;
    __device__ __forceinline__ void operator()(const f32x4 (&acc)[2][2][4][2], const Unit& u, int wr, int wc, int fr, int fq) const {
        const int row0 = u.pm * BM + wr * 64 + fr, col0 = u.pn * HALF + wc * 32 + 8 * fq;
#pragma unroll
        for (int ai = 0; ai < 2; ++ai)
#pragma unroll
            for (int m = 0; m < 4; ++m) { bf16_t* rowp = O + (size_t)(row0 + ai * HALF + m * 16) * ldc + col0;
                f32x4 h0, h1;
#pragma unroll
                for (int j = 0; j < 4; ++j) { const float g0 = acc[ai][0][m][0][j], g1 = acc[ai][0][m][1][j];
                    h0[j] = g0 * fast_sigmoid(g0) * acc[ai][1][m][0][j]; h1[j] = g1 * fast_sigmoid(g1) * acc[ai][1][m][1][j]; }
                u32x4 w; w.x = cvt_pk_bf16(h0[0], h0[1]); w.y = cvt_pk_bf16(h0[2], h0[3]); w.z = cvt_pk_bf16(h1[0], h1[1]); w.w = cvt_pk_bf16(h1[2], h1[3]);
                *(u32x4*)rowp = w; }
    }
};
struct EpiGLU {
    static constexpr bool PERM = true, AFTER_DRAIN = false;
    bf16_t* O; const bf16_t* Z; const float* bias; int ldc;
    __device__ __forceinline__ void operator()(const f32x4 (&acc)[2][2][4][2], const Unit& u, int wr, int wc, int fr, int fq) const {
        const int row0 = u.pm * BM + wr * 64 + fr, col0 = u.pn * BM + wc * 32 + 8 * fq;
#pragma unroll
        for (int ai = 0; ai < 2; ++ai)
#pragma unroll
            for (int m = 0; m < 4; ++m) { const size_t off = (size_t)(row0 + ai * HALF + m * 16) * ldc + col0;
#pragma unroll
                for (int bj = 0; bj < 2; ++bj) { const u32x4 zz = *(const u32x4*)(Z + off + bj * HALF);
                    const f32x4 b0 = *(const f32x4*)(bias + col0 + bj * HALF), b1 = *(const f32x4*)(bias + col0 + bj * HALF + 4);
                    const f32x4 v0 = acc[ai][bj][m][0] + b0, v1 = acc[ai][bj][m][1] + b1;
                    float z[8]; z[0] = __uint_as_float(zz.x << 16); z[1] = __uint_as_float(zz.x & 0xffff0000u); z[2] = __uint_as_float(zz.y << 16); z[3] = __uint_as_float(zz.y & 0xffff0000u);
                    z[4] = __uint_as_float(zz.z << 16); z[5] = __uint_as_float(zz.z & 0xffff0000u); z[6] = __uint_as_float(zz.w << 16); z[7] = __uint_as_float(zz.w & 0xffff0000u);
                    u32x4 w; w.x = cvt_pk_bf16(z[0] * fast_sigmoid(v0[0]), z[1] * fast_sigmoid(v0[1])); w.y = cvt_pk_bf16(z[2] * fast_sigmoid(v0[2]), z[3] * fast_sigmoid(v0[3]));
                    w.z = cvt_pk_bf16(z[4] * fast_sigmoid(v1[0]), z[5] * fast_sigmoid(v1[1])); w.w = cvt_pk_bf16(z[6] * fast_sigmoid(v1[2]), z[7] * fast_sigmoid(v1[3]));
                    *(u32x4*)(O + off + bj * HALF) = w; } }
    }
};
typedef unsigned u32x2 __attribute__((ext_vector_type(2)));
__device__ __forceinline__ unsigned cvt4_fp8(float a, float b, float c, float d) {
    a = __builtin_fminf(__builtin_fmaxf(a, -448.f), 448.f); b = __builtin_fminf(__builtin_fmaxf(b, -448.f), 448.f); c = __builtin_fminf(__builtin_fmaxf(c, -448.f), 448.f); d = __builtin_fminf(__builtin_fmaxf(d, -448.f), 448.f);
    unsigned w = 0u; w = __builtin_amdgcn_cvt_pk_fp8_f32(a, b, w, false); w = __builtin_amdgcn_cvt_pk_fp8_f32(c, d, w, true); return w; }
struct EpiStoreScaled {
    static constexpr bool PERM = true, AFTER_DRAIN = false;
    bf16_t* O; int ldc; float scale;
    __device__ __forceinline__ void operator()(const f32x4 (&acc)[2][2][4][2], const Unit& u, int wr, int wc, int fr, int fq) const {
        const int row0 = u.pm * BM + wr * 64 + fr, col0 = u.pn * BM + wc * 32 + 8 * fq;
#pragma unroll
        for (int ai = 0; ai < 2; ++ai)
#pragma unroll
            for (int m = 0; m < 4; ++m) { bf16_t* rowp = O + (size_t)(row0 + ai * HALF + m * 16) * ldc + col0;
#pragma unroll
                for (int bj = 0; bj < 2; ++bj) { const f32x4 v0 = acc[ai][bj][m][0] * scale, v1 = acc[ai][bj][m][1] * scale;
                    u32x4 w; w.x = cvt_pk_bf16(v0[0], v0[1]); w.y = cvt_pk_bf16(v0[2], v0[3]); w.z = cvt_pk_bf16(v1[0], v1[1]); w.w = cvt_pk_bf16(v1[2], v1[3]);
                    *(u32x4*)(rowp + bj * HALF) = w; } }
    }
};
struct EpiSwiGLU8 {
    static constexpr bool PERM = true, AFTER_DRAIN = false;
    unsigned char* O; int ldc; float s_in, s_out;
    __device__ __forceinline__ void operator()(const f32x4 (&acc)[2][2][4][2], const Unit& u, int wr, int wc, int fr, int fq) const {
        const int row0 = u.pm * BM + wr * 64 + fr, col0 = u.pn * HALF + wc * 32 + 8 * fq; const float kE = -s_in * 1.4426950408889634f, iC = 1.0f / (s_in * s_in * s_out);
#pragma unroll
        for (int ai = 0; ai < 2; ++ai)
#pragma unroll
            for (int m = 0; m < 4; ++m) { unsigned char* rowp = O + (size_t)(row0 + ai * HALF + m * 16) * ldc + col0;
                float h[8];
#pragma unroll
                for (int n = 0; n < 2; ++n) { const f32x4 g = acc[ai][0][m][n], uu = acc[ai][1][m][n]; const f32x4 t = g * kE; f32x4 ex, r;
#pragma unroll
                    for (int j = 0; j < 4; ++j) ex[j] = __builtin_amdgcn_exp2f(t[j]);
                    const f32x4 d = ex * iC + iC;
#pragma unroll
                    for (int j = 0; j < 4; ++j) r[j] = __builtin_amdgcn_rcpf(d[j]);
                    const f32x4 hv = (g * uu) * r; h[4 * n] = hv[0]; h[4 * n + 1] = hv[1]; h[4 * n + 2] = hv[2]; h[4 * n + 3] = hv[3]; }
                u32x2 w; w.x = cvt4_fp8(h[0], h[1], h[2], h[3]); w.y = cvt4_fp8(h[4], h[5], h[6], h[7]);
                *(u32x2*)rowp = w; }
    }
};
struct EpiSwiGLUi8 {
    static constexpr bool PERM = true, AFTER_DRAIN = false;
    bf16_t* O; int ldc; const float* rowscale; const unsigned* colmax;
    __device__ __forceinline__ void operator()(const f32x4 (&acc)[2][2][4][2], const Unit& u, int wr, int wc, int fr, int fq) const {
        typedef int i32x4_ __attribute__((ext_vector_type(4)));
        const int row0 = u.pm * BM + wr * 64 + fr, col0 = u.pn * HALF + wc * 32 + 8 * fq, n0 = u.pn * BM + wc * 32 + 8 * fq;
        const f32x4 cg0 = *(const f32x4*)(colmax + n0) * (1.0f / 127.0f), cg1 = *(const f32x4*)(colmax + n0 + 4) * (1.0f / 127.0f), cu0 = *(const f32x4*)(colmax + n0 + HALF) * (1.0f / 127.0f), cu1 = *(const f32x4*)(colmax + n0 + HALF + 4) * (1.0f / 127.0f);
        const f32x4 ke0 = cg0 * -1.4426950408889634f, ke1 = cg1 * -1.4426950408889634f, cc0 = cg0 * cu0, cc1 = cg1 * cu1;
#pragma unroll
        for (int ai = 0; ai < 2; ++ai)
#pragma unroll
            for (int m = 0; m < 4; ++m) { const int row = row0 + ai * HALF + m * 16; bf16_t* rowp = O + (size_t)row * ldc + col0; const float rs = rowscale[row];
                const i32x4_ g0i = __builtin_bit_cast(i32x4_, acc[ai][0][m][0]), g1i = __builtin_bit_cast(i32x4_, acc[ai][0][m][1]), u0i = __builtin_bit_cast(i32x4_, acc[ai][1][m][0]), u1i = __builtin_bit_cast(i32x4_, acc[ai][1][m][1]);
                f32x4 h0, h1;
                { const f32x4 gs = __builtin_convertvector(g0i, f32x4) * rs, us = __builtin_convertvector(u0i, f32x4) * rs; const f32x4 t = gs * ke0; f32x4 ex, r;
#pragma unroll
                  for (int j = 0; j < 4; ++j) ex[j] = __builtin_amdgcn_exp2f(t[j]);
                  const f32x4 d = ex + 1.0f;
#pragma unroll
                  for (int j = 0; j < 4; ++j) r[j] = __builtin_amdgcn_rcpf(d[j]);
                  h0 = ((gs * us) * cc0) * r; }
                { const f32x4 gs = __builtin_convertvector(g1i, f32x4) * rs, us = __builtin_convertvector(u1i, f32x4) * rs; const f32x4 t = gs * ke1; f32x4 ex, r;
#pragma unroll
                  for (int j = 0; j < 4; ++j) ex[j] = __builtin_amdgcn_exp2f(t[j]);
                  const f32x4 d = ex + 1.0f;
#pragma unroll
                  for (int j = 0; j < 4; ++j) r[j] = __builtin_amdgcn_rcpf(d[j]);
                  h1 = ((gs * us) * cc1) * r; }
                u32x4 w; w.x = cvt_pk_bf16(h0[0], h0[1]); w.y = cvt_pk_bf16(h0[2], h0[3]); w.z = cvt_pk_bf16(h1[0], h1[1]); w.w = cvt_pk_bf16(h1[2], h1[3]);
                *(u32x4*)rowp = w; }
    }
};
struct EpiStoreI8 {
    static constexpr bool PERM = true, AFTER_DRAIN = false;
    bf16_t* O; int ldc; const float* rowscale; const unsigned* colmax;
    __device__ __forceinline__ void operator()(const f32x4 (&acc)[2][2][4][2], const Unit& u, int wr, int wc, int fr, int fq) const {
        typedef int i32x4_ __attribute__((ext_vector_type(4)));
        const int row0 = u.pm * BM + wr * 64 + fr, col0 = u.pn * BM + wc * 32 + 8 * fq;
        f32x4 cs[2][2];
#pragma unroll
        for (int bj = 0; bj < 2; ++bj) { cs[bj][0] = *(const f32x4*)(colmax + col0 + bj * HALF) * (1.0f / 127.0f); cs[bj][1] = *(const f32x4*)(colmax + col0 + bj * HALF + 4) * (1.0f / 127.0f); }
#pragma unroll
        for (int ai = 0; ai < 2; ++ai)
#pragma unroll
            for (int m = 0; m < 4; ++m) { const int row = row0 + ai * HALF + m * 16; bf16_t* rowp = O + (size_t)row * ldc + col0; const float rs = rowscale[row];
#pragma unroll
                for (int bj = 0; bj < 2; ++bj) { const i32x4_ v0 = __builtin_bit_cast(i32x4_, acc[ai][bj][m][0]), v1 = __builtin_bit_cast(i32x4_, acc[ai][bj][m][1]);
                    const f32x4 f0 = (__builtin_convertvector(v0, f32x4) * rs) * cs[bj][0], f1 = (__builtin_convertvector(v1, f32x4) * rs) * cs[bj][1];
                    u32x4 w; w.x = cvt_pk_bf16(f0[0], f0[1]); w.y = cvt_pk_bf16(f0[2], f0[3]); w.z = cvt_pk_bf16(f1[0], f1[1]); w.w = cvt_pk_bf16(f1[2], f1[3]);
                    *(u32x4*)(rowp + bj * HALF) = w; } }
    }
};
struct ExpertOrder {
    static constexpr bool SPLITK = false; static constexpr int NSPLIT = 1;
    int nM, nN, nwg, G, c; const int* tile_e;
    __device__ void init(int nM_, int nN_, int G_, int c_, const int* te) { nM = nM_; nN = nN_; nwg = nM * nN; G = G_; c = c_; tile_e = te; }
    __device__ bool next(int i, Unit& u) const {
        const long L = (long)i * G + c; if (L >= nwg) return false;
        int wgid = (int)L; { const int q = nwg / NXCD, r = nwg % NXCD, xcd = wgid % NXCD, off = wgid / NXCD; wgid = (xcd < r ? xcd * (q + 1) : r * (q + 1) + (xcd - r) * q) + off; }
        const int nig = WGM * nN, gid = wgid / nig, fm = gid * WGM, gsz = (nM - fm) < WGM ? (nM - fm) : WGM;
        u.pm = fm + ((wgid % nig) % gsz); u.pn = (wgid % nig) / gsz; u.pb = (tile_e ? tile_e[u.pm] : 0) * nN + u.pn; return true;
    }
    __device__ __forceinline__ void a_ready(const Unit&) const {}
    __device__ __forceinline__ void done(const Unit&) const {}
};
struct ExpertOrderSplit {
    static constexpr bool SPLITK = true; static constexpr int NSPLIT = 4;
    int nM, nN, NF, nfull, nwg, G, c; const int* tile_e;
    __device__ void init(int nM_, int nN_, int NF_, int G_, int c_, const int* te) { nM = nM_; nN = nN_; NF = nM_ < NF_ ? nM_ : NF_; nfull = NF * nN; nwg = nfull + (nM - NF) * nN * NSPLIT; G = G_; c = c_; tile_e = te; }
    __device__ bool next(int i, Unit& u) const {
        const long L = (long)i * G + c; if (L >= nwg) return false;
        if (L < nfull) { int wgid = (int)L; { const int q = nfull / NXCD, r = nfull % NXCD, xcd = wgid % NXCD, off = wgid / NXCD; wgid = (xcd < r ? xcd * (q + 1) : r * (q + 1) + (xcd - r) * q) + off; }
            const int nig = WGM * nN, gid = wgid / nig, fm = gid * WGM, gsz = (NF - fm) < WGM ? (NF - fm) : WGM;
            u.pm = fm + ((wgid % nig) % gsz); u.pn = (wgid % nig) / gsz; u.ks = -1; }
        else { const int idx = (int)L - nfull; u.ks = idx % NSPLIT; u.pn = (idx / NSPLIT) % nN; u.pm = NF + idx / (NSPLIT * nN); }
        u.pb = tile_e[u.pm] * nN + u.pn; return true;
    }
    __device__ __forceinline__ void a_ready(const Unit&) const {}
    __device__ __forceinline__ void done(const Unit&) const {}
};
struct EpiStoreScaledSplit {
    static constexpr bool PERM = true, AFTER_DRAIN = false;
    bf16_t* O; float* P; int ldc; float scale; int NF; size_t pslice;
    __device__ __forceinline__ void operator()(const f32x4 (&acc)[2][2][4][2], const Unit& u, int wr, int wc, int fr, int fq) const {
        const int col0 = u.pn * BM + wc * 32 + 8 * fq;
        if (u.ks < 0) { const int row0 = u.pm * BM + wr * 64 + fr;
#pragma unroll
            for (int ai = 0; ai < 2; ++ai)
#pragma unroll
                for (int m = 0; m < 4; ++m) { bf16_t* rowp = O + (size_t)(row0 + ai * HALF + m * 16) * ldc + col0;
#pragma unroll
                    for (int bj = 0; bj < 2; ++bj) { const f32x4 v0 = acc[ai][bj][m][0] * scale, v1 = acc[ai][bj][m][1] * scale;
                        u32x4 w; w.x = cvt_pk_bf16(v0[0], v0[1]); w.y = cvt_pk_bf16(v0[2], v0[3]); w.z = cvt_pk_bf16(v1[0], v1[1]); w.w = cvt_pk_bf16(v1[2], v1[3]);
                        *(u32x4*)(rowp + bj * HALF) = w; } } }
        else { const int row0 = (u.pm - NF) * BM + wr * 64 + fr; float* base = P + (size_t)u.ks * pslice;
#pragma unroll
            for (int ai = 0; ai < 2; ++ai)
#pragma unroll
                for (int m = 0; m < 4; ++m) { float* rowp = base + (size_t)(row0 + ai * HALF + m * 16) * ldc + col0;
#pragma unroll
                    for (int bj = 0; bj < 2; ++bj) { *(f32x4*)(rowp + bj * HALF) = acc[ai][bj][m][0] * scale; *(f32x4*)(rowp + bj * HALF + 4) = acc[ai][bj][m][1] * scale; } } }
    }
};
}
constexpr int NTOK = 16384, DM = 2048, SEQ = 4096, NBATCH = 4, NCHUNK = 64, CHUNK = 64;
constexpr int DIN = 5392, DINP = 5632;
constexpr int C_Q = 0, C_K = 1024, C_V = 2048, C_GATE = 3072, C_BQ = 4096, C_BK = 4608, C_BV = 4736, C_CU = 4864, C_AL = 5376, C_BE = 5384;
constexpr int DFF = 7168, NEXP = 8;
constexpr float EPS = 1e-6f;
#ifndef USE_FP8
#define USE_FP8 1
#endif
#ifndef FP8_E0
#define FP8_E0 1
#endif
#ifndef USE_I8
#define USE_I8 1
#endif
#ifndef USE_I8_WIN
#define USE_I8_WIN 1
#endif
constexpr float F8_SA = 16.f, F8_SW = 256.f, F8_SH = 8.f;
constexpr int NWAVES = 8, NTHR = 512;
constexpr int LDS_BYTES = 147456;
constexpr int LDS_MISC = 131072 + 8192;

constexpr size_t MiB = 1u << 20;
constexpr size_t WS_CTL = 0, CTL_BYTES = 1 * MiB;
constexpr size_t WS_S5TAB = 1 * MiB;
constexpr size_t WS_MISC = 2 * MiB;
constexpr size_t WS_WIN = 4 * MiB, WIN_BYTES = (size_t)DINP * DM * 2;
constexpr size_t WS_WOUT = 48 * MiB, WOUT_BYTES = (size_t)DM * DM * 2;
constexpr size_t WS_WGLU = 64 * MiB, WGLU_BYTES = 512 * 512 * 2;
constexpr size_t WS_FGU = 65 * MiB, GU_BYTES = (size_t)2 * DFF * DM * 2;
constexpr size_t WS_FD = 121 * MiB, D_BYTES = (size_t)DM * DFF * 2;
constexpr size_t WS_MGU = 149 * MiB;
constexpr size_t WS_MD = 597 * MiB;
constexpr size_t WS_HN = 821 * MiB;
constexpr size_t WS_R = 885 * MiB;
constexpr size_t WS_PROJ = WS_R;
constexpr size_t WS_MIXCAT = WS_R + 176 * MiB;
constexpr size_t WS_MIXOUT = WS_R + 240 * MiB;
constexpr size_t WS_Z = WS_R + 304 * MiB;
constexpr size_t WS_GLU = WS_R + 320 * MiB;
constexpr size_t WS_ATT = WS_R + 336 * MiB;
constexpr size_t WS_DNQKV = WS_R + 352 * MiB;
constexpr size_t WS_DNGB = WS_R + 544 * MiB;
constexpr size_t WS_DNO = WS_R + 545 * MiB;
constexpr size_t WS_XS = WS_R + 609 * MiB;
constexpr size_t WS_HID = WS_R;
constexpr size_t WS_XG = WS_R + 476 * MiB;
constexpr size_t WS_YG = WS_R + 612 * MiB;
constexpr size_t WS_YP = WS_R + 748 * MiB;
constexpr int YP_NF = 2 * NTOK / 256;
constexpr size_t YP_SLICE = (size_t)8 * 256 * DM;
constexpr size_t WS_S5E = WS_R + 865 * MiB;
constexpr size_t WS_END = WS_R + 869 * MiB;
constexpr int CW_BAR = 4096;
constexpr int CW_CNT = 16384;
constexpr int CW_COLMAX = 32768;
constexpr int CW_WMAX = 20480;
constexpr int MI_ROUTE = 0;
constexpr int MI_GATE = 65536;
constexpr int MI_ROWS = 65536 + 32768;
constexpr int MI_TILEE = 65536 + 65536;
constexpr int MI_NTILES = MI_TILEE + 256;
constexpr int MI_ROWSC = 196608;

#define LAS __attribute__((address_space(3)))
typedef unsigned short bf16;
typedef float f32x4 __attribute__((ext_vector_type(4)));
typedef float f32x2v __attribute__((ext_vector_type(2)));
typedef unsigned u32x4 __attribute__((ext_vector_type(4)));
typedef unsigned u32x2 __attribute__((ext_vector_type(2)));
typedef short bf16x8 __attribute__((ext_vector_type(8)));
#define LDS_WAIT() asm volatile("s_waitcnt lgkmcnt(0)" ::: "memory")
__device__ __forceinline__ float bflo(unsigned w) { return __uint_as_float(w << 16); }
__device__ __forceinline__ float bfhi(unsigned w) { return __uint_as_float(w & 0xffff0000u); }
__device__ __forceinline__ float bf2f(bf16 v) { return __uint_as_float(((unsigned)v) << 16); }
typedef __bf16 hwbf16x2 __attribute__((ext_vector_type(2)));
typedef float hwf32x2 __attribute__((ext_vector_type(2)));
__device__ __forceinline__ unsigned pk2(float lo, float hi) { const hwf32x2 v = {lo, hi}; return __builtin_bit_cast(unsigned, __builtin_convertvector(v, hwbf16x2)); }
__device__ __forceinline__ unsigned f2bf(float f) { return pk2(f, f) & 0xffffu; }
__device__ __forceinline__ float wave_sum(float v) {
#pragma unroll
    for (int o = 1; o < 64; o <<= 1) v += __shfl_xor(v, o);
    return v;
}
__device__ __forceinline__ float siluf(float x) { return x * __builtin_amdgcn_rcpf(1.0f + __expf(-x)); }
__device__ __forceinline__ float sigmoidf_(float x) { return __builtin_amdgcn_rcpf(1.0f + __expf(-x)); }
__device__ __forceinline__ float softplusf_(float x) { return x > 20.f ? x : log1pf(__expf(x)); }
__device__ __forceinline__ float gelu_tanh(float y) { const float t = 0.7978845608028654f * (y + 0.044715f * y * y * y); return 0.5f * y * (1.0f + tanhf(t)); }

struct Args { const float* in[28]; float* out; unsigned char* ws; };
struct Frame {
    LAS unsigned char* lds;
    int tid, lane, wave, G, bid;
    int gw, ngw;
    int gt, ngt;
    float* out; unsigned char* ws;
};
#define IN_X 0
#define IN_LNG 1
#define IN_WIN 2
#define IN_CONVW 3
#define IN_ALOG 4
#define IN_DTB 5
#define IN_ANORM 6
#define IN_SINKS 7
#define IN_BNORM 8
#define IN_LAMRE 9
#define IN_LAMIM 10
#define IN_LOGDT 11
#define IN_BRE 12
#define IN_BIM 13
#define IN_CRE 14
#define IN_CIM 15
#define IN_S5D 16
#define IN_WGLU 17
#define IN_BGLU 18
#define IN_CNORM 19
#define IN_WOUT 20
#define IN_FWG 21
#define IN_FWU 22
#define IN_FWD 23
#define IN_WR 24
#define IN_MWG 25
#define IN_MWU 26
#define IN_MWD 27

struct TrJob { const float* src; bf16* dst; int ld, K, nv4; };
__device__ __forceinline__ bool tr_decode(const Args& A, unsigned char* ws, int it, TrJob& J) {
    constexpr int I_WIN = 32 * 88, I_WOUT = 32 * 32, I_GLU = 8 * 8, I_GU = 32 * 224, I_D = 112 * 32;
    constexpr int NITEMS = 2 * I_WIN + 2 * I_WOUT + 2 * I_GLU + 9 * I_GU + 9 * I_D;
    if (it >= NITEMS) return false;
    int r = it;
    if (r < 9 * I_GU) { const int e = r / I_GU; r -= e * I_GU; const int kb = r / 224, nb = r % 224, n0 = 64 * nb, k0 = 64 * kb, tile = n0 >> 8, within = n0 & 255;
        const float* g = e == 0 ? A.in[IN_FWG] : A.in[IN_MWG] + (size_t)(e - 1) * DM * DFF; const float* u = e == 0 ? A.in[IN_FWU] : A.in[IN_MWU] + (size_t)(e - 1) * DM * DFF;
        J.src = (within < 128 ? g : u) + (size_t)k0 * DFF + 128 * tile + (within & 127); J.ld = DFF; J.nv4 = 16; J.K = DM;
        J.dst = (bf16*)(ws + (e == 0 ? WS_FGU : WS_MGU + (size_t)(e - 1) * GU_BYTES)) + (size_t)n0 * DM + k0; return true; }
    r -= 9 * I_GU;
    if (r < 9 * I_D) { const int e = r / I_D; r -= e * I_D; const int kb = r / 32, nb = r % 32, n0 = 64 * nb, k0 = 64 * kb;
        J.src = (e == 0 ? A.in[IN_FWD] : A.in[IN_MWD] + (size_t)(e - 1) * DFF * DM) + (size_t)k0 * DM + n0; J.ld = DM; J.nv4 = 16; J.K = DFF;
        J.dst = (bf16*)(ws + (e == 0 ? WS_FD : WS_MD + (size_t)(e - 1) * D_BYTES)) + (size_t)n0 * DFF + k0; return true; }
    r -= 9 * I_D;
    if (r < 2 * I_WIN) { const int l = r / I_WIN; r -= l * I_WIN; const int kb = r / 88, nb = r % 88, n0 = 64 * nb, k0 = 64 * kb;
        int col, nv; if (n0 < 4096) { col = n0; nv = 16; } else if (n0 < 5376) { col = n0 + 16; nv = 16; } else if (n0 == 5376) { col = 4096; nv = 4; } else { col = 0; nv = 0; }
        J.src = A.in[IN_WIN] + (size_t)l * DM * DIN + (size_t)k0 * DIN + col; J.ld = DIN; J.nv4 = nv; J.K = DM; J.dst = (bf16*)(ws + WS_WIN + l * WIN_BYTES) + (size_t)n0 * DM + k0; return true; }
    r -= 2 * I_WIN;
    if (r < 2 * I_WOUT) { const int l = r / I_WOUT; r -= l * I_WOUT; const int kb = r / 32, nb = r % 32, n0 = 64 * nb, k0 = 64 * kb;
        J.src = A.in[IN_WOUT] + (size_t)l * DM * DM + (size_t)k0 * DM + n0; J.ld = DM; J.nv4 = 16; J.K = DM; J.dst = (bf16*)(ws + WS_WOUT + l * WOUT_BYTES) + (size_t)n0 * DM + k0; return true; }
    r -= 2 * I_WOUT;
    { const int l = r / I_GLU; r -= l * I_GLU; const int kb = r / 8, nb = r % 8, n0 = 64 * nb, k0 = 64 * kb;
        J.src = A.in[IN_WGLU] + (size_t)l * 512 * 512 + (size_t)k0 * 512 + n0; J.ld = 512; J.nv4 = 16; J.K = 512; J.dst = (bf16*)(ws + WS_WGLU + l * WGLU_BYTES) + (size_t)n0 * 512 + k0; return true; }
}
__device__ __forceinline__ void tr_load(const TrJob& J, int lane, f32x4 (&v)[16]) {
    const int q = lane >> 4, c = lane & 15; const float* p = J.src + (size_t)(2 * q) * J.ld + (c < J.nv4 ? 4 * c : 0);
#pragma unroll
    for (int i = 0; i < 8; ++i) { v[2 * i] = *(const f32x4*)(p + (size_t)(8 * i) * J.ld); v[2 * i + 1] = *(const f32x4*)(p + (size_t)(8 * i + 1) * J.ld); }
}
__device__ __forceinline__ void tr_store(const TrJob& J, int lane, const f32x4 (&v)[16], LAS unsigned* scr) {
    const int q = lane >> 4, c = lane & 15; const unsigned keep = c < J.nv4 ? 0xffffffffu : 0u;
#pragma unroll
    for (int i = 0; i < 8; ++i)
#pragma unroll
        for (int j = 0; j < 4; ++j) scr[(4 * c + j) * 33 + q + 4 * i] = pk2(v[2 * i][j], v[2 * i + 1][j]) & keep;
    LDS_WAIT(); asm volatile("" ::: "memory");
    const int ch = lane & 7;
#pragma unroll
    for (int m = 0; m < 8; ++m) { const int n = (lane >> 3) + 8 * m; const LAS unsigned* s = scr + n * 33 + 4 * ch;
        u32x4 o; o.x = s[0]; o.y = s[1]; o.z = s[2]; o.w = s[3]; *(u32x4*)(J.dst + (size_t)n * J.K + 8 * ch) = o; }
    LDS_WAIT(); asm volatile("" ::: "memory");
}
__device__ __forceinline__ void tr8_load(const TrJob& J, int lane, f32x4 (&v)[16]) {
    const int q = lane >> 3, c = lane & 7; const float* p = J.src + (size_t)(4 * q) * J.ld + 4 * c;
#pragma unroll
    for (int i = 0; i < 4; ++i)
#pragma unroll
        for (int kk = 0; kk < 4; ++kk) v[4 * i + kk] = *(const f32x4*)(p + (size_t)(32 * i + kk) * J.ld);
}
__device__ __forceinline__ void tr8_store(const TrJob& J, int lane, const f32x4 (&v)[16], LAS unsigned* scr) {
    const int q = lane >> 3, c = lane & 7;
#pragma unroll
    for (int i = 0; i < 4; ++i)
#pragma unroll
        for (int j = 0; j < 4; ++j) scr[(4 * c + j) * 33 + q + 8 * i] = pg8::cvt4_fp8(v[4 * i][j] * F8_SW, v[4 * i + 1][j] * F8_SW, v[4 * i + 2][j] * F8_SW, v[4 * i + 3][j] * F8_SW);
    LDS_WAIT(); asm volatile("" ::: "memory");
    const int ch = lane & 7;
#pragma unroll
    for (int m = 0; m < 4; ++m) { const int n = (lane >> 3) + 8 * m; const LAS unsigned* s = scr + n * 33 + 4 * ch;
        u32x4 o; o.x = s[0]; o.y = s[1]; o.z = s[2]; o.w = s[3]; *(u32x4*)((unsigned char*)J.dst + (size_t)n * J.K + 16 * ch) = o; }
    LDS_WAIT(); asm volatile("" ::: "memory");
}
__device__ __forceinline__ bool tr8_decode(const Args& A, unsigned char* ws, int it, TrJob& J) {
    constexpr int I_GU = 16 * 448, I_D = 56 * 64, NS = 9 - FP8_E0;
    if (it >= NS * (I_GU + I_D)) return false;
    int r = it;
    if (r < NS * I_GU) { const int e = FP8_E0 + r / I_GU; r %= I_GU; const int kb = r / 448, nb = r % 448, n0 = 32 * nb, k0 = 128 * kb, tile = n0 >> 8, within = n0 & 255;
        const float* g = e == 0 ? A.in[IN_FWG] : A.in[IN_MWG] + (size_t)(e - 1) * DM * DFF; const float* u = e == 0 ? A.in[IN_FWU] : A.in[IN_MWU] + (size_t)(e - 1) * DM * DFF;
        J.src = (within < 128 ? g : u) + (size_t)k0 * DFF + 128 * tile + (within & 127); J.ld = DFF; J.nv4 = 16; J.K = DM;
        J.dst = (bf16*)(ws + (e == 0 ? WS_FGU : WS_MGU + (size_t)(e - 1) * (GU_BYTES / 2)) + (size_t)n0 * DM + k0); return true; }
    r -= NS * I_GU;
    { const int e = FP8_E0 + r / I_D; r %= I_D; const int kb = r / 64, nb = r % 64, n0 = 32 * nb, k0 = 128 * kb;
        J.src = (e == 0 ? A.in[IN_FWD] : A.in[IN_MWD] + (size_t)(e - 1) * DFF * DM) + (size_t)k0 * DM + n0; J.ld = DM; J.nv4 = 16; J.K = DFF;
        J.dst = (bf16*)(ws + (e == 0 ? WS_FD : WS_MD + (size_t)(e - 1) * (D_BYTES / 2)) + (size_t)n0 * DFF + k0); return true; }
}
__device__ __forceinline__ bool tr_decode_c(const Args& A, unsigned char* ws, int j, TrJob& J) {
    constexpr int I_GU = 32 * 224, I_D = 112 * 32;
#if USE_FP8
    constexpr int NBG = USE_I8 ? 0 : FP8_E0, NBD = FP8_E0;
    constexpr int SKIPW = USE_I8_WIN ? 2 * 32 * 88 : 0;
    int it; if (j < NBG * I_GU) it = j; else if (j < NBG * I_GU + NBD * I_D) it = 9 * I_GU + (j - NBG * I_GU); else it = 9 * (I_GU + I_D) + SKIPW + (j - NBG * I_GU - NBD * I_D);
    return tr_decode(A, ws, it, J);
#else
    return tr_decode(A, ws, j, J);
#endif
}
__device__ __forceinline__ void p0_weights(const Args& A, const Frame& F) {
    LAS unsigned* scr = (LAS unsigned*)(F.lds + F.wave * 16384);
    TrJob ja, jb; f32x4 va[16], vb[16];
#if USE_FP8
    { int it = F.gw; bool ha = tr8_decode(A, F.ws, it, ja); if (ha) tr8_load(ja, F.lane, va);
      while (ha) {
        it += F.ngw; const bool hb = tr8_decode(A, F.ws, it, jb); if (hb) tr8_load(jb, F.lane, vb);
        tr8_store(ja, F.lane, va, scr);
        if (!hb) break;
        it += F.ngw; ha = tr8_decode(A, F.ws, it, ja); if (ha) tr8_load(ja, F.lane, va);
        tr8_store(jb, F.lane, vb, scr);
      } }
#endif
    int it = F.gw;
    bool ha = tr_decode_c(A, F.ws, it, ja); if (ha) tr_load(ja, F.lane, va);
    while (ha) {
        it += F.ngw; const bool hb = tr_decode_c(A, F.ws, it, jb); if (hb) tr_load(jb, F.lane, vb);
        tr_store(ja, F.lane, va, scr);
        if (!hb) break;
        it += F.ngw; ha = tr_decode_c(A, F.ws, it, ja); if (ha) tr_load(ja, F.lane, va);
        tr_store(jb, F.lane, vb, scr);
    }
}
__device__ __forceinline__ unsigned cvt4_i8(float a, float b, float c, float d) {
    const int ia = (int)__builtin_rintf(fminf(fmaxf(a, -127.f), 127.f)), ib = (int)__builtin_rintf(fminf(fmaxf(b, -127.f), 127.f)), ic = (int)__builtin_rintf(fminf(fmaxf(c, -127.f), 127.f)), id = (int)__builtin_rintf(fminf(fmaxf(d, -127.f), 127.f));
    return (unsigned)(ia & 0xff) | ((unsigned)(ib & 0xff) << 8) | ((unsigned)(ic & 0xff) << 16) | ((unsigned)id << 24); }
__device__ __forceinline__ void p0_i8_strips(const Args& A, const Frame& F) {
    unsigned* ctl = (unsigned*)(F.ws + WS_CTL);
    LAS unsigned* scr = (LAS unsigned*)(F.lds + F.wave * 8704);
    LAS float* red = (LAS float*)(F.lds + 8 * 8704);
    LAS float* cmax = red + 32 * 64;
    constexpr int T_WIN = USE_I8_WIN ? 88 : 0, T_GU = 224, NT = 2 * T_WIN + T_GU;
    for (int task = F.bid; task < NT; task += F.G) {
        int tid = F.tid; asm volatile("" : "+v"(tid));
        const int lane = tid & 63, wave = __builtin_amdgcn_readfirstlane(tid >> 6);
        const float* src; int ld, nvalid; unsigned char* dst; unsigned* cm;
        if (task < 2 * T_WIN) { const int l = task / T_WIN, n0 = 64 * (task % T_WIN); const int col = n0 < 4096 ? n0 : (n0 < 5376 ? n0 + 16 : 4096); nvalid = n0 < 5376 ? 64 : (n0 == 5376 ? 16 : 0);
            src = A.in[IN_WIN] + (size_t)l * DM * DIN + col; ld = DIN; dst = F.ws + WS_WIN + l * WIN_BYTES + (size_t)n0 * DM; cm = ctl + CW_COLMAX + l * DINP + n0; }
        else { const int n0 = 64 * (task - 2 * T_WIN), tile = n0 >> 8, within = n0 & 255; nvalid = 64;
            src = (within < 128 ? A.in[IN_FWG] : A.in[IN_FWU]) + 128 * tile + (within & 127); ld = DFF; dst = F.ws + WS_FGU + (size_t)n0 * DM; cm = ctl + CW_COLMAX + 2 * DINP + n0; }
        { const int c4 = tid & 15, rg = tid >> 4; const bool ok = 4 * c4 < nvalid; const float* p = src + (size_t)rg * ld + (ok ? 4 * c4 : 0);
          f32x4 m = (f32x4){0.f, 0.f, 0.f, 0.f};
#pragma unroll 16
          for (int i = 0; i < 64; ++i) { const f32x4 v = *(const f32x4*)(p + (size_t)(32 * i) * ld); m[0] = fmaxf(m[0], fabsf(v[0])); m[1] = fmaxf(m[1], fabsf(v[1])); m[2] = fmaxf(m[2], fabsf(v[2])); m[3] = fmaxf(m[3], fabsf(v[3])); }
          __syncthreads();
          *(LAS f32x4*)(red + rg * 64 + 4 * c4) = ok ? m : (f32x4){0.f, 0.f, 0.f, 0.f};
          __syncthreads();
          if (tid < 64) { float mx = 0.f;
#pragma unroll
              for (int g = 0; g < 32; ++g) mx = fmaxf(mx, red[g * 64 + tid]);
              cmax[tid] = mx; cm[tid] = __float_as_uint(mx); }
          __syncthreads(); }
        for (int it = wave; it < 32; it += NWAVES) { const int kb = it >> 1, nh = it & 1;
            const int q = lane >> 3, c = lane & 7; const bool ok = 32 * nh + 4 * c < nvalid;
            const float* p = src + (size_t)(128 * kb + 4 * q) * ld + (ok ? 32 * nh + 4 * c : 0);
            f32x4 v[16];
#pragma unroll
            for (int i = 0; i < 4; ++i)
#pragma unroll
                for (int kk = 0; kk < 4; ++kk) v[4 * i + kk] = *(const f32x4*)(p + (size_t)(32 * i + kk) * ld);
            float s4[4];
#pragma unroll
            for (int j = 0; j < 4; ++j) { const float mxc = cmax[32 * nh + 4 * c + j]; s4[j] = (ok && mxc > 0.f) ? 127.0f / mxc : 0.f; }
#pragma unroll
            for (int i = 0; i < 4; ++i)
#pragma unroll
                for (int j = 0; j < 4; ++j) scr[(4 * c + j) * 33 + q + 8 * i] = cvt4_i8(v[4 * i][j] * s4[j], v[4 * i + 1][j] * s4[j], v[4 * i + 2][j] * s4[j], v[4 * i + 3][j] * s4[j]);
            LDS_WAIT(); asm volatile("" ::: "memory");
            const int ch = lane & 7;
#pragma unroll
            for (int m = 0; m < 4; ++m) { const int n = (lane >> 3) + 8 * m; const LAS unsigned* sp = scr + n * 33 + 4 * ch;
                u32x4 o; o.x = sp[0]; o.y = sp[1]; o.z = sp[2]; o.w = sp[3]; *(u32x4*)(dst + (size_t)(32 * nh + n) * DM + 128 * kb + 16 * ch) = o; }
            LDS_WAIT(); asm volatile("" ::: "memory"); }
    }
    __syncthreads();
}
__device__ __forceinline__ void p0_s5tab(const Args& A, const Frame& F) {
    float* tab = (float*)(F.ws + WS_S5TAB);
    for (int i = F.gt; i < 2 * 32 * 64; i += F.ngt) {
        const int lg = i >> 6;
        const float dt = expf(A.in[IN_LOGDT][lg]);
        const float lr = fminf(A.in[IN_LAMRE][i], -1e-4f), li = A.in[IN_LAMIM][i];
        const float mag = expf(lr * dt), ab_re = mag * cosf(li * dt), ab_im = mag * sinf(li * dt);
        const float den = lr * lr + li * li, nr = ab_re - 1.0f;
        const float coef_re = (nr * lr + ab_im * li) / den, coef_im = (ab_im * lr - nr * li) / den;
        float* t = tab + (size_t)i * 36; t[0] = ab_re; t[1] = ab_im; t[2] = 0.f; t[3] = 0.f;
        for (int h = 0; h < 16; ++h) { const float br = A.in[IN_BRE][(size_t)i * 16 + h], bi = A.in[IN_BIM][(size_t)i * 16 + h];
            t[4 + h] = coef_re * br - coef_im * bi; t[20 + h] = coef_re * bi + coef_im * br; }
    }
}

__device__ __forceinline__ void ld_row_f32(const float* p, int lane, f32x4 (&v)[8]) {
#pragma unroll
    for (int j = 0; j < 8; ++j) v[j] = ((const f32x4*)p)[64 * j + lane];
}
__device__ __forceinline__ void ld_row_bf16(const bf16* p, int lane, f32x4 (&v)[8]) {
#pragma unroll
    for (int j = 0; j < 8; ++j) { const u32x2 w = ((const u32x2*)p)[64 * j + lane]; v[j] = (f32x4){bflo(w.x), bfhi(w.x), bflo(w.y), bfhi(w.y)}; }
}
__device__ __forceinline__ void st_row_bf16(bf16* p, int lane, const f32x4 (&v)[8]) {
#pragma unroll
    for (int j = 0; j < 8; ++j) { u32x2 w; w.x = pk2(v[j][0], v[j][1]); w.y = pk2(v[j][2], v[j][3]); ((u32x2*)p)[64 * j + lane] = w; }
}
__device__ __forceinline__ void st_row_fp8(unsigned char* p, int lane, const f32x4 (&v)[8], float s) {
#pragma unroll
    for (int j = 0; j < 8; ++j) ((unsigned*)p)[64 * j + lane] = pg8::cvt4_fp8(v[j][0] * s, v[j][1] * s, v[j][2] * s, v[j][3] * s);
}
__device__ __forceinline__ void st_row_f32(float* p, int lane, const f32x4 (&v)[8]) {
#pragma unroll
    for (int j = 0; j < 8; ++j) ((f32x4*)p)[64 * j + lane] = v[j];
}
__device__ __forceinline__ float row_sumsq(const f32x4 (&v)[8]) {
    float s = 0.f;
#pragma unroll
    for (int j = 0; j < 8; ++j) s += (v[j][0] * v[j][0] + v[j][1] * v[j][1]) + (v[j][2] * v[j][2] + v[j][3] * v[j][3]);
    return wave_sum(s);
}
__device__ __forceinline__ void st_row_i8(unsigned char* p, float* rowscale, int lane, const f32x4 (&x)[8]) {
    float mx = 0.f;
#pragma unroll
    for (int j = 0; j < 8; ++j) mx = fmaxf(fmaxf(mx, fmaxf(fabsf(x[j][0]), fabsf(x[j][1]))), fmaxf(fabsf(x[j][2]), fabsf(x[j][3])));
#pragma unroll
    for (int o = 1; o < 64; o <<= 1) mx = fmaxf(mx, __shfl_xor(mx, o));
    mx = fmaxf(mx, 1e-20f); const float sq = 127.0f / mx;
#pragma unroll
    for (int j = 0; j < 8; ++j) ((unsigned*)p)[64 * j + lane] = cvt4_i8(x[j][0] * sq, x[j][1] * sq, x[j][2] * sq, x[j][3] * sq);
    if (lane == 0) *rowscale = mx * (1.0f / 127.0f);
}
__device__ __forceinline__ void rp_norm1(const Args& A, const Frame& F, const float* x, const float* gain, bf16* hn) {
    for (int m = F.gw; m < NTOK; m += F.ngw) {
        f32x4 v[8], g[8]; ld_row_f32(x + (size_t)m * DM, F.lane, v); ld_row_f32(gain, F.lane, g);
        const float rstd = rsqrtf(row_sumsq(v) * (1.0f / DM) + EPS);
#pragma unroll
        for (int j = 0; j < 8; ++j) v[j] = v[j] * rstd * g[j];
        if (USE_I8_WIN) st_row_i8((unsigned char*)hn + (size_t)m * DM, (float*)(F.ws + WS_MISC) + MI_ROWSC + m, F.lane, v);
        else st_row_bf16(hn + (size_t)m * DM, F.lane, v);
    }
}
__device__ __forceinline__ void rp_post_mixer(const Args& A, const Frame& F, const float* xsrc, const bf16* mix, const float* g1, const float* g2, bf16* hn, bool moe, const float* wr) {
    unsigned* ctl = (unsigned*)(F.ws + WS_CTL); int* misc = (int*)(F.ws + WS_MISC);
    LAS float* wt = (LAS float*)F.lds;
    if (moe) {
        for (int i = F.tid; i < DM * 2; i += NTHR) { const int k = i >> 1, hf = i & 1; const f32x4 w4 = *(const f32x4*)(wr + (size_t)k * 8 + 4 * hf);
            wt[(4 * hf + 0) * DM + k] = w4[0]; wt[(4 * hf + 1) * DM + k] = w4[1]; wt[(4 * hf + 2) * DM + k] = w4[2]; wt[(4 * hf + 3) * DM + k] = w4[3]; }
        __syncthreads(); }
    for (int m = F.gw; m < NTOK; m += F.ngw) {
        f32x4 v[8], x[8], g[8]; ld_row_bf16(mix + (size_t)m * DM, F.lane, v); ld_row_f32(xsrc + (size_t)m * DM, F.lane, x); ld_row_f32(g1, F.lane, g);
        const float r1 = rsqrtf(row_sumsq(v) * (1.0f / DM) + EPS);
#pragma unroll
        for (int j = 0; j < 8; ++j) x[j] = x[j] + v[j] * r1 * g[j];
        st_row_f32(F.out + (size_t)m * DM, F.lane, x);
        ld_row_f32(g2, F.lane, g);
        const float r2 = rsqrtf(row_sumsq(x) * (1.0f / DM) + EPS);
#pragma unroll
        for (int j = 0; j < 8; ++j) x[j] = x[j] * r2 * g[j];
        if (USE_FP8 && (moe || FP8_E0 == 0)) st_row_fp8((unsigned char*)hn + (size_t)m * DM, F.lane, x, F8_SA);
        else if (USE_I8) {
            float mx = 0.f;
#pragma unroll
            for (int j = 0; j < 8; ++j) mx = fmaxf(fmaxf(mx, fmaxf(fabsf(x[j][0]), fabsf(x[j][1]))), fmaxf(fabsf(x[j][2]), fabsf(x[j][3])));
#pragma unroll
            for (int o = 1; o < 64; o <<= 1) mx = fmaxf(mx, __shfl_xor(mx, o));
            mx = fmaxf(mx, 1e-20f); const float sq = 127.0f / mx;
#pragma unroll
            for (int j = 0; j < 8; ++j) ((unsigned*)((unsigned char*)hn + (size_t)m * DM))[64 * j + F.lane] = cvt4_i8(x[j][0] * sq, x[j][1] * sq, x[j][2] * sq, x[j][3] * sq);
            if (F.lane == 0) ((float*)misc)[MI_ROWSC + m] = mx * (1.0f / 127.0f); }
        else st_row_bf16(hn + (size_t)m * DM, F.lane, x);
        if (moe) {
            float lg[8];
#pragma unroll
            for (int e = 0; e < 8; ++e) lg[e] = 0.f;
#pragma unroll
            for (int j = 0; j < 8; ++j) { asm volatile("" ::: "memory");
#pragma unroll
                for (int e = 0; e < 8; ++e) { const f32x4 w4 = *(const LAS f32x4*)(wt + e * DM + 256 * j + 4 * F.lane);
                    lg[e] += (x[j][0] * w4[0] + x[j][1] * w4[1]) + (x[j][2] * w4[2] + x[j][3] * w4[3]); } }
#pragma unroll
            for (int e = 0; e < 8; ++e) lg[e] = wave_sum(lg[e]);
            int e1 = 0; float v1 = lg[0];
#pragma unroll
            for (int e = 1; e < 8; ++e) if (lg[e] > v1) { v1 = lg[e]; e1 = e; }
            int e2 = -1; float v2 = -3.0e38f;
#pragma unroll
            for (int e = 0; e < 8; ++e) if (e != e1 && lg[e] > v2) { v2 = lg[e]; e2 = e; }
            if (F.lane == 0) {
                const float ga = 1.0f / (1.0f + expf(v2 - v1));
                const int p1 = (int)atomicAdd(ctl + CW_CNT + 64 * e1, 1u), p2 = (int)atomicAdd(ctl + CW_CNT + 64 * e2, 1u);
                misc[MI_ROUTE + 4 * m + 0] = e1; misc[MI_ROUTE + 4 * m + 1] = e2; misc[MI_ROUTE + 4 * m + 2] = p1; misc[MI_ROUTE + 4 * m + 3] = p2;
                ((float*)misc)[MI_GATE + 2 * m + 0] = ga; ((float*)misc)[MI_GATE + 2 * m + 1] = 1.0f - ga;
            }
        }
    }
}
__device__ __forceinline__ void moe_dispatch(const Args& A, const Frame& F, const bf16* hn) {
    unsigned* ctl = (unsigned*)(F.ws + WS_CTL); int* misc = (int*)(F.ws + WS_MISC);
    LAS int* tb = (LAS int*)(F.lds);
    if (F.tid == 0) { int off = 0; for (int e = 0; e < 8; ++e) { const int c = (int)__hip_atomic_load(ctl + CW_CNT + 64 * e, __ATOMIC_RELAXED, __HIP_MEMORY_SCOPE_AGENT); const int t = (c + 255) >> 8; tb[e] = c; tb[8 + e] = off * 256; tb[16 + e] = t * 256;
            if (F.bid == 0) for (int i = 0; i < t; ++i) misc[MI_TILEE + off + i] = e;
            off += t; }
        if (F.bid == 0) misc[MI_NTILES] = off; }
    __syncthreads();
    constexpr int RB = USE_FP8 ? DM : 2 * DM, NV = RB / 1024;
    unsigned char* xg = F.ws + WS_XG;
    for (int m = F.gw; m < NTOK; m += F.ngw) {
        const int e1 = misc[MI_ROUTE + 4 * m], e2 = misc[MI_ROUTE + 4 * m + 1], p1 = misc[MI_ROUTE + 4 * m + 2], p2 = misc[MI_ROUTE + 4 * m + 3];
        const int r1 = tb[8 + e1] + p1, r2 = tb[8 + e2] + p2;
        if (F.lane == 0) { misc[MI_ROWS + 2 * m] = r1; misc[MI_ROWS + 2 * m + 1] = r2; }
        const u32x4* s = (const u32x4*)((const unsigned char*)hn + (size_t)m * RB); u32x4* d1 = (u32x4*)(xg + (size_t)r1 * RB); u32x4* d2 = (u32x4*)(xg + (size_t)r2 * RB);
#pragma unroll
        for (int j = 0; j < NV; ++j) { const u32x4 w = s[64 * j + F.lane]; d1[64 * j + F.lane] = w; d2[64 * j + F.lane] = w; }
    }
    for (int i = F.gw; i < 8 * 256; i += F.ngw) { const int e = i >> 8, r = tb[e] + (i & 255);
        if (r < tb[16 + e]) { u32x4* d = (u32x4*)(xg + (size_t)(tb[8 + e] + r) * RB);
#pragma unroll
            for (int j = 0; j < NV; ++j) d[64 * j + F.lane] = (u32x4){0u, 0u, 0u, 0u}; } }
    __syncthreads();
}
__device__ __forceinline__ void rp_post_ffn(const Args& A, const Frame& F, const bf16* fo, bool moe, const float* g3, const float* g0n, bf16* hn) {
    const int* misc = (const int*)(F.ws + WS_MISC);
    for (int m = F.gw; m < NTOK; m += F.ngw) {
        f32x4 v[8], x[8], g[8];
        if (moe) { const int r1 = misc[MI_ROWS + 2 * m], r2 = misc[MI_ROWS + 2 * m + 1]; const float ga = ((const float*)misc)[MI_GATE + 2 * m], gb = ((const float*)misc)[MI_GATE + 2 * m + 1];
            if (r1 < 256 * YP_NF && r2 < 256 * YP_NF) { ld_row_bf16(fo + (size_t)r1 * DM, F.lane, v); ld_row_bf16(fo + (size_t)r2 * DM, F.lane, x);
#pragma unroll
                for (int j = 0; j < 8; ++j) v[j] = v[j] * ga + x[j] * gb; }
            else {
                const float* yp = (const float*)(F.ws + WS_YP);
#pragma unroll
                for (int which = 0; which < 2; ++which) { const int rr = which ? r2 : r1; f32x4 (&d)[8] = which ? x : v;
                    if (rr < 256 * YP_NF) ld_row_bf16(fo + (size_t)rr * DM, F.lane, d);
                    else { ld_row_f32(yp + (size_t)(rr - 256 * YP_NF) * DM, F.lane, d);
                        for (int s = 1; s < 4; ++s) { ld_row_f32(yp + s * YP_SLICE + (size_t)(rr - 256 * YP_NF) * DM, F.lane, g);
#pragma unroll
                            for (int j = 0; j < 8; ++j) d[j] = d[j] + g[j]; }
#pragma unroll
                        for (int j = 0; j < 8; ++j) { const unsigned w0 = pk2(d[j][0], d[j][1]), w1 = pk2(d[j][2], d[j][3]); d[j] = (f32x4){bflo(w0), bfhi(w0), bflo(w1), bfhi(w1)}; } } }
#pragma unroll
                for (int j = 0; j < 8; ++j) v[j] = v[j] * ga + x[j] * gb; } }
        else ld_row_bf16(fo + (size_t)m * DM, F.lane, v);
        ld_row_f32(F.out + (size_t)m * DM, F.lane, x); ld_row_f32(g3, F.lane, g);
        const float r1 = rsqrtf(row_sumsq(v) * (1.0f / DM) + EPS);
#pragma unroll
        for (int j = 0; j < 8; ++j) x[j] = x[j] + v[j] * r1 * g[j];
        st_row_f32(F.out + (size_t)m * DM, F.lane, x);
        if (g0n) { ld_row_f32(g0n, F.lane, g); const float r2 = rsqrtf(row_sumsq(x) * (1.0f / DM) + EPS);
#pragma unroll
            for (int j = 0; j < 8; ++j) x[j] = x[j] * r2 * g[j];
            if (USE_I8_WIN) st_row_i8((unsigned char*)hn + (size_t)m * DM, (float*)(F.ws + WS_MISC) + MI_ROWSC + m, F.lane, x);
            else st_row_bf16(hn + (size_t)m * DM, F.lane, x); }
    }
}
#define XB_TMO      128
#define XB_XCNT(j)  (256  + 64 * (j))
#define XB_XSUB(j)  (1280 + 64 * (j))
#define XB_XGEN(j)  (2304 + 64 * (j))
#define XB_TOP      3328
#define XB_TOPGEN   3392
#define XCD_BAR_WORDS 3456
#define XB_SPIN_CAP (1u << 18)

__device__ __forceinline__ unsigned xb_ld(unsigned* p)              { return __hip_atomic_load(p, __ATOMIC_RELAXED, __HIP_MEMORY_SCOPE_AGENT); }
__device__ __forceinline__ unsigned xb_add(unsigned* p, unsigned v) { return __hip_atomic_fetch_add(p, v, __ATOMIC_RELAXED, __HIP_MEMORY_SCOPE_AGENT); }
__device__ __forceinline__ unsigned xb_xcc_id() { return (unsigned)__builtin_amdgcn_s_getreg((3 << 11) | 20) & 0xFu; }
#define XB_SPIN(cond, bar) do { unsigned _sp = 0; while (cond) { __builtin_amdgcn_s_sleep(1); \
    if ((++_sp & 255u) == 0u) { if (xb_ld(&(bar)[XB_TMO])) break; if (_sp > XB_SPIN_CAP) { atomicAdd(&(bar)[XB_TMO], 1u); break; } } } } while (0)

struct XcdBarrier {
    unsigned* bar; unsigned x;
    volatile LAS unsigned* st;
};

__device__ __forceinline__ XcdBarrier xcd_barrier_post(unsigned* bar, volatile LAS unsigned* st) {
    XcdBarrier b; b.bar = bar; b.x = xb_xcc_id(); b.st = st;
    if (threadIdx.x == 0) (void)xb_add(&bar[XB_XCNT(b.x)], 1u);
    return b;
}
__device__ __forceinline__ void xcd_barrier_complete(unsigned* bar, unsigned x, unsigned& nloc, unsigned& nx) {
    const unsigned G = gridDim.x * gridDim.y * gridDim.z;
    unsigned sum, cnt, mine, sp = 0u;
    for (;;) {
        sum = 0u; cnt = 0u; mine = 0u;
#pragma unroll
        for (unsigned j = 0; j < 16; ++j) { const unsigned c = xb_ld(&bar[XB_XCNT(j)]); sum += c; cnt += (c > 0u) ? 1u : 0u; mine = (j == x) ? c : mine; }
        if (sum == G) break;
        __builtin_amdgcn_s_sleep(1);
        if ((++sp & 255u) == 0u) { if (xb_ld(&bar[XB_TMO])) break; if (sp > XB_SPIN_CAP) { atomicAdd(&bar[XB_TMO], 1u); break; } }
    }
    nloc = mine > 0u ? mine : 1u; nx = cnt > 0u ? cnt : 1u;
}

__device__ __forceinline__ void xcd_barrier(const XcdBarrier& b) {
    asm volatile("s_waitcnt vmcnt(0)" ::: "memory");
    __syncthreads();
    if (threadIdx.x == 0) {
        unsigned* bar = b.bar;
        __builtin_amdgcn_s_waitcnt(0);
        unsigned nloc = b.st[0], nx = b.st[1];
        if (nloc == 0u) { xcd_barrier_complete(bar, b.x, nloc, nx); b.st[0] = nloc; b.st[1] = nx; }
        const unsigned old = xb_add(&bar[XB_XSUB(b.x)], 1u);
        const unsigned gen = old / nloc;
        if (old + 1u == (gen + 1u) * nloc) {
            __builtin_amdgcn_fence(__ATOMIC_RELEASE, "agent");
            asm volatile("s_waitcnt vmcnt(0)" ::: "memory");
            const unsigned og = xb_add(&bar[XB_TOP], 1u);
            const unsigned tg = og / nx;
            if (og + 1u == (tg + 1u) * nx) xb_add(&bar[XB_TOPGEN], 1u);
            else XB_SPIN(xb_ld(&bar[XB_TOPGEN]) == tg, bar);
            __builtin_amdgcn_fence(__ATOMIC_ACQUIRE, "agent");
            xb_add(&bar[XB_XGEN(b.x)], 1u);
            asm volatile("s_waitcnt vmcnt(0)" ::: "memory");
        } else {
            XB_SPIN(xb_ld(&bar[XB_XGEN(b.x)]) == gen, bar);
            __builtin_amdgcn_fence(__ATOMIC_ACQUIRE, "agent");
            asm volatile("s_waitcnt vmcnt(0)" ::: "memory");
        }
    }
    __syncthreads();
}
__device__ __forceinline__ void dn_prep_naive(const Args& A, const Frame& F, int layer) {
    const bf16* proj = (const bf16*)(F.ws + WS_PROJ); float* qkv = (float*)(F.ws + WS_DNQKV); float* gb = (float*)(F.ws + WS_DNGB);
    const float* cw = A.in[IN_CONVW] + (size_t)layer * 4 * 3072;
    for (int it = F.gw; it < NTOK * 8; it += F.ngw) {
        const int n = it >> 3, h = it & 7, l = n & (SEQ - 1);
        float a[3][2];
#pragma unroll
        for (int s = 0; s < 3; ++s) { a[s][0] = 0.f; a[s][1] = 0.f; }
#pragma unroll
        for (int j = 0; j < 4; ++j) { if (l - 3 + j >= 0) { const bf16* row = proj + (size_t)(n - 3 + j) * DINP;
#pragma unroll
                for (int s = 0; s < 3; ++s) { const unsigned w = *(const unsigned*)(row + s * 1024 + h * 128 + 2 * F.lane); const f32x2v c = *(const f32x2v*)(cw + j * 3072 + s * 1024 + h * 128 + 2 * F.lane);
                    a[s][0] += bflo(w) * c.x; a[s][1] += bfhi(w) * c.y; } } }
#pragma unroll
        for (int s = 0; s < 3; ++s) { a[s][0] = siluf(a[s][0]); a[s][1] = siluf(a[s][1]); }
        const float rq = rsqrtf(wave_sum(a[0][0] * a[0][0] + a[0][1] * a[0][1]) + EPS) * 0.08838834764831845f;
        const float rk = rsqrtf(wave_sum(a[1][0] * a[1][0] + a[1][1] * a[1][1]) + EPS);
        float* o = qkv + (size_t)it * 384 + 2 * F.lane;
        *(f32x2v*)(o) = (f32x2v){a[0][0] * rq, a[0][1] * rq}; *(f32x2v*)(o + 128) = (f32x2v){a[1][0] * rk, a[1][1] * rk}; *(f32x2v*)(o + 256) = (f32x2v){a[2][0], a[2][1]};
        if (F.lane == 0) { const float al = bf2f(proj[(size_t)n * DINP + C_AL + h]), be = bf2f(proj[(size_t)n * DINP + C_BE + h]);
            gb[(size_t)it * 2] = -expf(A.in[IN_ALOG][layer * 8 + h]) * softplusf_(al + A.in[IN_DTB][layer * 8 + h]); gb[(size_t)it * 2 + 1] = sigmoidf_(be); }
    }
}
__device__ __forceinline__ void dn_scan_naive(const Args& A, const Frame& F, int tsk) {
    const float* qkv = (const float*)(F.ws + WS_DNQKV); const float* gb = (const float*)(F.ws + WS_DNGB); float* oo = (float*)(F.ws + WS_DNO);
    const int b = tsk >> 5, h = (tsk >> 2) & 7, col = (tsk & 3) * 32 + (F.lane >> 1), half = F.lane & 1;
    float S[64];
#pragma unroll
    for (int m = 0; m < 64; ++m) S[m] = 0.f;
    for (int t = 0; t < SEQ; ++t) {
        const size_t it = (size_t)(b * SEQ + t) * 8 + h; const float* base = qkv + it * 384;
        const float eg = expf(gb[it * 2]), beta = gb[it * 2 + 1];
        const f32x4* kp = (const f32x4*)(base + 128 + 64 * half); const f32x4* qp = (const f32x4*)(base + 64 * half);
        float dot = 0.f;
#pragma unroll
        for (int seg = 0; seg < 4; ++seg) {
#pragma unroll
            for (int m4 = 4 * seg; m4 < 4 * seg + 4; ++m4) { const f32x4 k = kp[m4];
#pragma unroll
                for (int c = 0; c < 4; ++c) { S[4 * m4 + c] *= eg; dot += k[c] * S[4 * m4 + c]; } }
            asm volatile("" ::: "memory"); }
        dot += __shfl_xor(dot, 1);
        const float delta = beta * (base[256 + col] - dot);
        float o = 0.f;
#pragma unroll
        for (int seg = 0; seg < 4; ++seg) {
#pragma unroll
            for (int m4 = 4 * seg; m4 < 4 * seg + 4; ++m4) { const f32x4 k = kp[m4], q = qp[m4];
#pragma unroll
                for (int c = 0; c < 4; ++c) { S[4 * m4 + c] += k[c] * delta; o += q[c] * S[4 * m4 + c]; } }
            asm volatile("" ::: "memory"); }
        o += __shfl_xor(o, 1);
        if (half == 0) oo[(size_t)(b * SEQ + t) * 1024 + h * 128 + col] = o;
    }
}
__device__ __forceinline__ void dn_finalize_naive(const Args& A, const Frame& F, int layer) {
    const bf16* proj = (const bf16*)(F.ws + WS_PROJ); const float* oo = (const float*)(F.ws + WS_DNO); bf16* mc = (bf16*)(F.ws + WS_MIXCAT);
    const f32x2v an = *(const f32x2v*)(A.in[IN_ANORM] + layer * 128 + 2 * F.lane);
    for (int it = F.gw; it < NTOK * 8; it += F.ngw) {
        const int n = it >> 3, h = it & 7;
        const f32x2v o = *(const f32x2v*)(oo + (size_t)n * 1024 + h * 128 + 2 * F.lane);
        const float r = rsqrtf(wave_sum(o.x * o.x + o.y * o.y) * (1.0f / 128.0f) + EPS);
        const unsigned gw = *(const unsigned*)(proj + (size_t)n * DINP + C_GATE + h * 128 + 2 * F.lane);
        *(unsigned*)(mc + (size_t)n * DM + h * 128 + 2 * F.lane) = pk2(o.x * r * an.x * siluf(bflo(gw)), o.y * r * an.y * siluf(bfhi(gw)));
    }
}
__device__ __forceinline__ void swa_naive(const Args& A, const Frame& F, int layer) {
    const bf16* proj = (const bf16*)(F.ws + WS_PROJ); bf16* att = (bf16*)(F.ws + WS_ATT);
    for (int idx = F.gt; idx < NTOK * 8; idx += F.ngt) {
        const int n = idx >> 3, h = idx & 7, b = n >> 12, l = n & (SEQ - 1), c = l >> 6, kvh = h >> 2;
        const int c0 = c >= 2 ? c - 2 : 0, k0 = b * SEQ + c0 * 64, k1 = b * SEQ + (c + 1) * 64;
        const float sink = A.in[IN_SINKS][layer * 8 + h];
        float q[64], o[64];
        { const u32x4* qp = (const u32x4*)(proj + (size_t)n * DINP + C_BQ + h * 64);
#pragma unroll
          for (int i = 0; i < 8; ++i) { const u32x4 w = qp[i]; q[8 * i] = bflo(w.x) * 0.125f; q[8 * i + 1] = bfhi(w.x) * 0.125f; q[8 * i + 2] = bflo(w.y) * 0.125f; q[8 * i + 3] = bfhi(w.y) * 0.125f;
              q[8 * i + 4] = bflo(w.z) * 0.125f; q[8 * i + 5] = bfhi(w.z) * 0.125f; q[8 * i + 6] = bflo(w.w) * 0.125f; q[8 * i + 7] = bfhi(w.w) * 0.125f; } }
        float mx = sink;
        for (int m = k0; m < k1; ++m) { const u32x4* kp = (const u32x4*)(proj + (size_t)m * DINP + C_BK + kvh * 64); float s = 0.f;
#pragma unroll
            for (int i = 0; i < 8; ++i) { const u32x4 w = kp[i]; s += q[8 * i] * bflo(w.x) + q[8 * i + 1] * bfhi(w.x) + q[8 * i + 2] * bflo(w.y) + q[8 * i + 3] * bfhi(w.y) + q[8 * i + 4] * bflo(w.z) + q[8 * i + 5] * bfhi(w.z) + q[8 * i + 6] * bflo(w.w) + q[8 * i + 7] * bfhi(w.w); }
            mx = fmaxf(mx, s); }
        float den = expf(sink - mx);
#pragma unroll
        for (int d = 0; d < 64; ++d) o[d] = 0.f;
        for (int m = k0; m < k1; ++m) { const u32x4* kp = (const u32x4*)(proj + (size_t)m * DINP + C_BK + kvh * 64); const u32x4* vp = (const u32x4*)(proj + (size_t)m * DINP + C_BV + kvh * 64); float s = 0.f;
#pragma unroll
            for (int i = 0; i < 8; ++i) { const u32x4 w = kp[i]; s += q[8 * i] * bflo(w.x) + q[8 * i + 1] * bfhi(w.x) + q[8 * i + 2] * bflo(w.y) + q[8 * i + 3] * bfhi(w.y) + q[8 * i + 4] * bflo(w.z) + q[8 * i + 5] * bfhi(w.z) + q[8 * i + 6] * bflo(w.w) + q[8 * i + 7] * bfhi(w.w); }
            const float p = expf(s - mx); den += p;
#pragma unroll
            for (int i = 0; i < 8; ++i) { const u32x4 w = vp[i]; o[8 * i] += p * bflo(w.x); o[8 * i + 1] += p * bfhi(w.x); o[8 * i + 2] += p * bflo(w.y); o[8 * i + 3] += p * bfhi(w.y); o[8 * i + 4] += p * bflo(w.z); o[8 * i + 5] += p * bfhi(w.z); o[8 * i + 6] += p * bflo(w.w); o[8 * i + 7] += p * bfhi(w.w); } }
        const float inv = 1.0f / den; u32x4* op = (u32x4*)(att + (size_t)n * 512 + h * 64);
#pragma unroll
        for (int i = 0; i < 8; ++i) { u32x4 w; w.x = pk2(o[8 * i] * inv, o[8 * i + 1] * inv); w.y = pk2(o[8 * i + 2] * inv, o[8 * i + 3] * inv); w.z = pk2(o[8 * i + 4] * inv, o[8 * i + 5] * inv); w.w = pk2(o[8 * i + 6] * inv, o[8 * i + 7] * inv); op[i] = w; }
    }
}
__device__ __forceinline__ void s5_scan_naive(const Args& A, const Frame& F, int layer, int tsk) {
    const bf16* proj = (const bf16*)(F.ws + WS_PROJ); f32x2v* xs = (f32x2v*)(F.ws + WS_XS);
    const int b = tsk >> 5, g = tsk & 31, p = F.lane;
    const float* t = (const float*)(F.ws + WS_S5TAB) + (size_t)((layer * 32 + g) * 64 + p) * 36;
    const float ar = t[0], ai = t[1]; float br[16], bi[16];
#pragma unroll
    for (int h = 0; h < 16; ++h) { br[h] = t[4 + h]; bi[h] = t[20 + h]; }
    float xr = 0.f, xi = 0.f;
    for (int s = 0; s < SEQ; ++s) { const int n = b * SEQ + s; const u32x4* up = (const u32x4*)(proj + (size_t)n * DINP + C_CU + g * 16); const u32x4 w0 = up[0], w1 = up[1];
        float u[16]; u[0] = bflo(w0.x); u[1] = bfhi(w0.x); u[2] = bflo(w0.y); u[3] = bfhi(w0.y); u[4] = bflo(w0.z); u[5] = bfhi(w0.z); u[6] = bflo(w0.w); u[7] = bfhi(w0.w);
        u[8] = bflo(w1.x); u[9] = bfhi(w1.x); u[10] = bflo(w1.y); u[11] = bfhi(w1.y); u[12] = bflo(w1.z); u[13] = bfhi(w1.z); u[14] = bflo(w1.w); u[15] = bfhi(w1.w);
        float bur = 0.f, bui = 0.f;
#pragma unroll
        for (int h = 0; h < 16; ++h) { bur += u[h] * br[h]; bui += u[h] * bi[h]; }
        const float nr = ar * xr - ai * xi + bur, ni = ar * xi + ai * xr + bui; xr = nr; xi = ni;
        xs[((size_t)n * 32 + g) * 64 + p] = (f32x2v){xr, xi}; }
}
__device__ __forceinline__ void s5_out_naive(const Args& A, const Frame& F, int layer) {
    const bf16* proj = (const bf16*)(F.ws + WS_PROJ); const f32x2v* xs = (const f32x2v*)(F.ws + WS_XS); bf16* z = (bf16*)(F.ws + WS_Z);
    for (int idx = F.gt; idx < NTOK * 512; idx += F.ngt) {
        const int n = idx >> 9, gh = idx & 511, g = gh >> 4;
        const float* cr = A.in[IN_CRE] + (size_t)(layer * 512 + gh) * 64; const float* ci = A.in[IN_CIM] + (size_t)(layer * 512 + gh) * 64; const f32x2v* x = xs + ((size_t)n * 32 + g) * 64;
        float y = 0.f;
        for (int p = 0; p < 64; ++p) { const f32x2v xv = x[p]; y += xv.x * cr[p] - xv.y * ci[p]; }
        y += A.in[IN_S5D][layer * 512 + gh] * bf2f(proj[(size_t)n * DINP + C_CU + gh]);
        z[idx] = (bf16)f2bf(gelu_tanh(y));
    }
}
__device__ __forceinline__ void bc_finalize(const Args& A, const Frame& F, int layer, bool do_b, bool do_c) {
    bf16* mc = (bf16*)(F.ws + WS_MIXCAT);
    for (int n = F.gw; n < NTOK; n += F.ngw) {
#pragma unroll
        for (int part = 0; part < 2; ++part) { if (part == 0 ? !do_b : !do_c) continue;
            const bf16* src = (const bf16*)(F.ws + (part == 0 ? WS_ATT : WS_GLU)) + (size_t)n * 512 + 8 * F.lane; const float* gn = A.in[part == 0 ? IN_BNORM : IN_CNORM] + layer * 512 + 8 * F.lane;
            const u32x4 w = *(const u32x4*)src; float v[8]; v[0] = bflo(w.x); v[1] = bfhi(w.x); v[2] = bflo(w.y); v[3] = bfhi(w.y); v[4] = bflo(w.z); v[5] = bfhi(w.z); v[6] = bflo(w.w); v[7] = bfhi(w.w);
            float ss = 0.f;
#pragma unroll
            for (int i = 0; i < 8; ++i) ss += v[i] * v[i];
            const float r = rsqrtf(wave_sum(ss) * (1.0f / 512.0f) + EPS); const f32x4 g0 = *(const f32x4*)gn, g1 = *(const f32x4*)(gn + 4);
            u32x4 o; o.x = pk2(v[0] * r * g0[0], v[1] * r * g0[1]); o.y = pk2(v[2] * r * g0[2], v[3] * r * g0[3]); o.z = pk2(v[4] * r * g1[0], v[5] * r * g1[1]); o.w = pk2(v[6] * r * g1[2], v[7] * r * g1[3]);
            *(u32x4*)(mc + (size_t)n * DM + 1024 + part * 512 + 8 * F.lane) = o; }
    }
}
constexpr int SWA_KSTR = 72, SWA_VSTR = 200;
constexpr int SWA_LDS_K = 0, SWA_LDS_V = 2 * 192 * SWA_KSTR * 2, SWA_LDS_SS = SWA_LDS_V + 2 * 64 * SWA_VSTR * 2;
typedef short bf16x4 __attribute__((ext_vector_type(4)));
__device__ __forceinline__ void swa_mfma(const Args& A, const Frame& F, int layer) {
    const bf16* proj = (const bf16*)(F.ws + WS_PROJ); bf16* mc = (bf16*)(F.ws + WS_MIXCAT);
    LAS bf16* Ks = (LAS bf16*)(F.lds + SWA_LDS_K); LAS bf16* Vs = (LAS bf16*)(F.lds + SWA_LDS_V); LAS float* SS = (LAS float*)(F.lds + SWA_LDS_SS);
    const int h = F.wave, kvh = h >> 2, r = F.lane & 15, q = F.lane >> 4;
    const float sink = A.in[IN_SINKS][layer * 8 + h];
    for (int unit = F.bid; unit < NBATCH * NCHUNK; unit += F.G) {
        const int b = unit >> 6, c = unit & 63, t0 = b * SEQ + c * 64, key0 = t0 - 128;
        const int kvalid0 = c >= 2 ? 0 : (2 - c) * 64;
        __syncthreads();
        for (int pc = F.tid; pc < 2 * 192 * 8; pc += NTHR) {
            const int g8 = pc & 7, key = (pc >> 3) % 192, kv = pc / (192 * 8);
            u32x4 kw = (u32x4){0u, 0u, 0u, 0u}, vw = (u32x4){0u, 0u, 0u, 0u};
            if (key >= kvalid0) { const bf16* row = proj + (size_t)(key0 + key) * DINP; kw = *(const u32x4*)(row + C_BK + kv * 64 + 8 * g8); vw = *(const u32x4*)(row + C_BV + kv * 64 + 8 * g8); }
            *(LAS u32x4*)(Ks + (kv * 192 + key) * SWA_KSTR + 8 * g8) = kw;
            LAS bf16* vd = Vs + (kv * 64 + 8 * g8) * SWA_VSTR + ((((key >> 3) ^ g8) << 3) | (key & 7));
            vd[0 * SWA_VSTR] = (bf16)(vw.x & 0xffffu); vd[1 * SWA_VSTR] = (bf16)(vw.x >> 16); vd[2 * SWA_VSTR] = (bf16)(vw.y & 0xffffu); vd[3 * SWA_VSTR] = (bf16)(vw.y >> 16);
            vd[4 * SWA_VSTR] = (bf16)(vw.z & 0xffffu); vd[5 * SWA_VSTR] = (bf16)(vw.z >> 16); vd[6 * SWA_VSTR] = (bf16)(vw.w & 0xffffu); vd[7 * SWA_VSTR] = (bf16)(vw.w >> 16);
        }
        __syncthreads();
        f32x4 o[4][4];
        float ssq[4];
#pragma unroll
        for (int nt = 0; nt < 4; ++nt) {
            bf16x8 qf[2];
#pragma unroll
            for (int ks = 0; ks < 2; ++ks) qf[ks] = *(const bf16x8*)(proj + (size_t)(t0 + 16 * nt + r) * DINP + C_BQ + h * 64 + 32 * ks + 8 * q);
            f32x4 s[12];
#pragma unroll
            for (int mt = 0; mt < 12; ++mt) { s[mt] = (f32x4){0.f, 0.f, 0.f, 0.f};
#pragma unroll
                for (int ks = 0; ks < 2; ++ks) { const bf16x8 kf = *(const LAS bf16x8*)(Ks + (kvh * 192 + 16 * mt + r) * SWA_KSTR + 32 * ks + 8 * q);
                    s[mt] = __builtin_amdgcn_mfma_f32_16x16x32_bf16(kf, qf[ks], s[mt], 0, 0, 0); } }
            float m = sink;
#pragma unroll
            for (int mt = 0; mt < 12; ++mt) { const bool valid = (16 * mt >= kvalid0);
#pragma unroll
                for (int i = 0; i < 4; ++i) { s[mt][i] = valid ? s[mt][i] * 0.125f : -INFINITY; m = fmaxf(m, s[mt][i]); } }
            m = fmaxf(m, __shfl_xor(m, 16)); m = fmaxf(m, __shfl_xor(m, 32));
            float sum = 0.f;
#pragma unroll
            for (int mt = 0; mt < 12; ++mt)
#pragma unroll
                for (int i = 0; i < 4; ++i) { const float p = __expf(s[mt][i] - m); s[mt][i] = p; sum += p; }
            sum += __shfl_xor(sum, 16); sum += __shfl_xor(sum, 32);
            const float inv = 1.0f / (sum + __expf(sink - m));
#pragma unroll
            for (int mt = 0; mt < 4; ++mt) o[nt][mt] = (f32x4){0.f, 0.f, 0.f, 0.f};
#pragma unroll
            for (int ks = 0; ks < 6; ++ks) {
                u32x4 pw; pw.x = pk2(s[2 * ks][0] * inv, s[2 * ks][1] * inv); pw.y = pk2(s[2 * ks][2] * inv, s[2 * ks][3] * inv);
                pw.z = pk2(s[2 * ks + 1][0] * inv, s[2 * ks + 1][1] * inv); pw.w = pk2(s[2 * ks + 1][2] * inv, s[2 * ks + 1][3] * inv);
                const bf16x8 pf = __builtin_bit_cast(bf16x8, pw);
#pragma unroll
                for (int mt = 0; mt < 4; ++mt) { const int fe = (2 * mt + (r >> 3)) & 7; const LAS bf16* vp = Vs + (kvh * 64 + 16 * mt + r) * SWA_VSTR + 4 * (q & 1);
                    const u32x2 v0 = *(const LAS u32x2*)(vp + 8 * ((4 * ks + (q >> 1)) ^ fe)), v1 = *(const LAS u32x2*)(vp + 8 * ((4 * ks + 2 + (q >> 1)) ^ fe));
                    const u32x4 vw = (u32x4){v0.x, v0.y, v1.x, v1.y};
                    o[nt][mt] = __builtin_amdgcn_mfma_f32_16x16x32_bf16(__builtin_bit_cast(bf16x8, vw), pf, o[nt][mt], 0, 0, 0); }
            }
            float ss = 0.f;
#pragma unroll
            for (int mt = 0; mt < 4; ++mt)
#pragma unroll
                for (int i = 0; i < 4; ++i) ss += o[nt][mt][i] * o[nt][mt][i];
            ss += __shfl_xor(ss, 16); ss += __shfl_xor(ss, 32);
            ssq[nt] = ss;
            if (q == 0) SS[h * 64 + 16 * nt + r] = ss;
        }
        __syncthreads();
        const float* bn = A.in[IN_BNORM] + layer * 512 + h * 64;
#pragma unroll
        for (int nt = 0; nt < 4; ++nt) {
            float tot = 0.f;
#pragma unroll
            for (int hh = 0; hh < 8; ++hh) tot += SS[hh * 64 + 16 * nt + r];
            const float rs = rsqrtf(tot * (1.0f / 512.0f) + EPS);
#pragma unroll
            for (int mt = 0; mt < 4; ++mt) { const f32x4 g = *(const f32x4*)(bn + 16 * mt + 4 * q); const f32x4 v = o[nt][mt];
                u32x2 w; w.x = pk2(v[0] * rs * g[0], v[1] * rs * g[1]); w.y = pk2(v[2] * rs * g[2], v[3] * rs * g[3]);
                *(u32x2*)(mc + (size_t)(t0 + 16 * nt + r) * DM + 1024 + h * 64 + 16 * mt + 4 * q) = w; }
        }
        (void)ssq;
    }
}
typedef float f32x2p __attribute__((ext_vector_type(2)));
constexpr int S5_BSTR = 20;
constexpr int S5_XSTR = 136;
constexpr int S5_WAVE_LDS = 128 * S5_BSTR * 4 + 16 * S5_XSTR * 2;
template <bool WITH_OUT>
__device__ __forceinline__ void s5_chunk(const Args& A, const Frame& F, int layer, int gw, int ngw) {
    const bf16* proj = (const bf16*)(F.ws + WS_PROJ); f32x2v* Eg = (f32x2v*)(F.ws + WS_S5E); bf16* zb = (bf16*)(F.ws + WS_Z);
    LAS float* Bu = (LAS float*)(F.lds + F.wave * S5_WAVE_LDS); LAS bf16* Xb = (LAS bf16*)(F.lds + F.wave * S5_WAVE_LDS + 128 * S5_BSTR * 4);
    const int r = F.lane & 15, q = F.lane >> 4, p = F.lane;
    __syncthreads();
    int gcur = -1; float ar = 0.f, ai = 0.f, a64r = 0.f, a64i = 0.f; bf16x4 bbf[8]; bf16x8 cmf[4]; f32x4 dv = (f32x4){0.f, 0.f, 0.f, 0.f};
    for (int task = gw; task < NBATCH * 32 * NCHUNK; task += ngw) {
        const int c = task & 63, g = (task >> 6) & 31, b = task >> 11, t0 = b * SEQ + c * 64;
        u32x2 uall[4];
#pragma unroll
        for (int mt = 0; mt < 4; ++mt) uall[mt] = *(const u32x2*)(proj + (size_t)(t0 + 16 * mt + r) * DINP + C_CU + 16 * g + 4 * q);
        if (g != gcur) { gcur = g;
            const float* tab = (const float*)(F.ws + WS_S5TAB) + (size_t)((layer * 32 + g) * 64) * 36;
            ar = tab[p * 36]; ai = tab[p * 36 + 1];
#pragma unroll
            for (int nt = 0; nt < 8; ++nt) { const f32x4 v = *(const f32x4*)(tab + (size_t)((16 * nt + r) & 63) * 36 + 4 + 16 * (nt >> 2) + 4 * q);
                u32x2 w; w.x = pk2(v[0], v[1]); w.y = pk2(v[2], v[3]); bbf[nt] = __builtin_bit_cast(bf16x4, w); }
            if (WITH_OUT) {
#pragma unroll
                for (int ks = 0; ks < 4; ++ks) { const float* src = (ks < 2 ? A.in[IN_CRE] : A.in[IN_CIM]) + (size_t)((layer * 32 + g) * 16 + r) * 64 + 32 * (ks & 1) + 8 * q; const float sg = ks < 2 ? 1.f : -1.f;
                    const f32x4 v0 = *(const f32x4*)src, v1 = *(const f32x4*)(src + 4);
                    u32x4 w; w.x = pk2(sg * v0[0], sg * v0[1]); w.y = pk2(sg * v0[2], sg * v0[3]); w.z = pk2(sg * v1[0], sg * v1[1]); w.w = pk2(sg * v1[2], sg * v1[3]); cmf[ks] = __builtin_bit_cast(bf16x8, w); }
                dv = *(const f32x4*)(A.in[IN_S5D] + (layer * 32 + g) * 16 + 4 * q);
                a64r = ar; a64i = ai;
#pragma unroll
                for (int i = 0; i < 6; ++i) { const float nr = a64r * a64r - a64i * a64i, ni = 2.f * a64r * a64i; a64r = nr; a64i = ni; }
            } }
        float xr = 0.f, xi = 0.f;
        if (WITH_OUT) {
            const f32x2v* Ep = Eg + (size_t)(task - c) * 64 + p;
            for (int cc0 = 0; cc0 < c; cc0 += 16) {
                f32x2v e[16];
#pragma unroll
                for (int k = 0; k < 16; ++k) e[k] = Ep[(size_t)(cc0 + k < c ? cc0 + k : c - 1) * 64];
#pragma unroll
                for (int k = 0; k < 16; ++k) if (cc0 + k < c) { const float nr = a64r * xr - a64i * xi + e[k].x, ni = a64r * xi + a64i * xr + e[k].y; xr = nr; xi = ni; } }
        }
        f32x2p xv = (f32x2p){xr, xi}; const f32x2p a1v = (f32x2p){ar, ar}, a2v = (f32x2p){-ai, ai};
#pragma unroll
        for (int mt = 0; mt < 4; ++mt) {
            const u32x2 uw = uall[mt];
            const bf16x4 uf = __builtin_bit_cast(bf16x4, uw);
#pragma unroll
            for (int nt = 0; nt < 8; ++nt) { f32x4 d = (f32x4){0.f, 0.f, 0.f, 0.f}; d = __builtin_amdgcn_mfma_f32_16x16x16bf16_1k(uf, bbf[nt], d, 0, 0, 0);
                *(LAS f32x4*)(Bu + (16 * nt + r) * S5_BSTR + 4 * q) = d; }
            LDS_WAIT(); asm volatile("" ::: "memory");
            f32x4 bre[4], bim[4];
#pragma unroll
            for (int k4 = 0; k4 < 4; ++k4) { bre[k4] = *(const LAS f32x4*)(Bu + p * S5_BSTR + 4 * k4); bim[k4] = *(const LAS f32x4*)(Bu + (64 + p) * S5_BSTR + 4 * k4); }
#pragma unroll
            for (int t = 0; t < 16; ++t) {
                f32x2p nb = (f32x2p){bre[t >> 2][t & 3], bim[t >> 2][t & 3]};
                asm("v_pk_fma_f32 %0, %1, %2, %0" : "+v"(nb) : "v"(a1v), "v"(xv));
                asm("v_pk_fma_f32 %0, %1, %2, %0 op_sel:[0,1,0] op_sel_hi:[1,0,1]" : "+v"(nb) : "v"(a2v), "v"(xv));
                xv = nb;
                if (WITH_OUT) { const unsigned w = pk2(xv[0], xv[1]); Xb[t * S5_XSTR + p] = (bf16)(w & 0xffffu); Xb[t * S5_XSTR + 64 + p] = (bf16)(w >> 16); } }
            LDS_WAIT(); asm volatile("" ::: "memory");
            if (WITH_OUT) {
                f32x4 y = (f32x4){0.f, 0.f, 0.f, 0.f};
#pragma unroll
                for (int ks = 0; ks < 4; ++ks) { const bf16x8 xf = *(const LAS bf16x8*)(Xb + r * S5_XSTR + 32 * ks + 8 * q); y = __builtin_amdgcn_mfma_f32_16x16x32_bf16(cmf[ks], xf, y, 0, 0, 0); }
                const float u0 = bflo(uw.x), u1 = bfhi(uw.x), u2 = bflo(uw.y), u3 = bfhi(uw.y);
                u32x2 w; w.x = pk2(gelu_tanh(y[0] + dv[0] * u0), gelu_tanh(y[1] + dv[1] * u1)); w.y = pk2(gelu_tanh(y[2] + dv[2] * u2), gelu_tanh(y[3] + dv[3] * u3));
                *(u32x2*)(zb + (size_t)(t0 + 16 * mt + r) * 512 + 16 * g + 4 * q) = w;
                LDS_WAIT(); asm volatile("" ::: "memory");
            }
        }
        if (!WITH_OUT) Eg[(size_t)task * 64 + p] = (f32x2v){xv[0], xv[1]};
    }
}
constexpr int DNL_QN = 0, DNL_KN = 17408, DNL_VT = 34816, DNL_KT = 53248, DNL_KDT = 71680, DNL_LM = 90112, DNL_AT = 107520, DNL_SM = 116736, DNL_CW = 117760;
constexpr int DN_RS = 136, DN_TS = 72, DN_LS = 68;
constexpr size_t WS_DNW = WS_R + 352 * MiB;
constexpr size_t WS_DNN = WS_R + 416 * MiB;
constexpr size_t WS_DNQ = WS_R + 480 * MiB;
constexpr size_t WS_DNOL = WS_R + 512 * MiB;
constexpr size_t WS_DNS = WS_R + 544 * MiB;
constexpr size_t WS_DNEG = WS_R + 608 * MiB;
__device__ __forceinline__ int dn_pos(int d) { const int ks = d >> 5, w = d & 31, sub = w >> 4, qq = (w >> 2) & 3, i = w & 3; return 32 * ks + 8 * qq + 4 * sub + i; }

__device__ __forceinline__ void dn_fmac(float& acc, float a, float b) { asm("v_fmac_f32 %0, %1, %2" : "+v"(acc) : "v"(a), "v"(b)); }
typedef float f32x2p __attribute__((ext_vector_type(2)));
__device__ __forceinline__ void dn_pkfma(f32x2p& acc, f32x2p a, f32x2p b) { asm("v_pk_fma_f32 %0, %1, %2, %0" : "+v"(acc) : "v"(a), "v"(b)); }
template <int I> struct DnSolveRow { static __device__ __forceinline__ void run(f32x2p (&xp)[16], const LAS float* LMp, int par) {
    DnSolveRow<I - 1>::run(xp, LMp, par);
    constexpr int NJ = (I + 3) / 4, NG = (NJ + 1) / 2; f32x2p a01 = (f32x2p){0.f, 0.f}, a23 = (f32x2p){0.f, 0.f};
    f32x4 l[NG];
#pragma unroll
    for (int g = 0; g < NG; ++g) l[g] = *(const LAS f32x4*)(LMp + I * DN_LS + 8 * g);
#pragma unroll
    for (int g = 0; g < NG; ++g) { dn_pkfma(a01, __builtin_shufflevector(l[g], l[g], 0, 1), xp[2 * g]); dn_pkfma(a23, __builtin_shufflevector(l[g], l[g], 2, 3), xp[2 * g + 1]); }
    f32x2p s01; asm("v_pk_add_f32 %0, %1, %2" : "=v"(s01) : "v"(a01), "v"(a23)); float part; asm("v_add_f32 %0, %1, %2" : "=v"(part) : "v"(s01[0]), "v"(s01[1]));
    const float tot = part + __builtin_bit_cast(float, __builtin_amdgcn_update_dpp(0, __builtin_bit_cast(int, part), 0xB1, 0xF, 0xF, false));
    constexpr int OWN = (I >> 2) & 1, SLOT = 4 * (I >> 3) + (I & 3);
    xp[SLOT >> 1][SLOT & 1] = (par == OWN) ? xp[SLOT >> 1][SLOT & 1] - tot : xp[SLOT >> 1][SLOT & 1];
    asm volatile("" ::: "memory"); } };
template <> struct DnSolveRow<0> { static __device__ __forceinline__ void run(f32x2p (&)[16], const LAS float*, int) {} };

#ifndef REP_DN1
#define REP_DN1 1
#endif
#ifndef REP_DN3
#define REP_DN3 1
#endif
#ifndef REP_DN5
#define REP_DN5 1
#endif
#ifndef REP_DN4
#define REP_DN4 1
#endif
template <int FAKE = 0> __device__ __forceinline__ void dn_chunk_prep(const Args& A, const Frame& F, int layer) {
    const bf16* proj = (const bf16*)(F.ws + WS_PROJ);
    const int upw = (NBATCH * 8 * NCHUNK + F.G - 1) / F.G; int hcur = -1;
    const int ubeg = F.bid * upw, uend = ((F.bid + 1) * upw < NBATCH * 8 * NCHUNK) ? (F.bid + 1) * upw : NBATCH * 8 * NCHUNK;
    u32x4 xr[4][3][2]; unsigned abw = 0u;
#define DN_PREFETCH(uo2_, tidp_) do { const int u2_ = (uo2_) < uend ? (uo2_) : uend - 1; const int h2_ = u2_ >> 8, c2_ = u2_ & 63, b2_ = (u2_ >> 6) & 3, t2_ = (tidp_) >> 3, s2_ = (tidp_) & 7, n2_ = b2_ * SEQ + c2_ * 64 + t2_; \
        _Pragma("unroll") for (int j = 0; j < 4; ++j) { const bool vj_ = (c2_ * 64 + t2_ - 3 + j) >= 0; const bf16* row_ = FAKE == 1 ? proj + 16 * s2_ : proj + (size_t)(vj_ ? n2_ - 3 + j : n2_) * DINP + h2_ * 128 + 16 * s2_; \
            _Pragma("unroll") for (int s = 0; s < 3; ++s) { xr[j][s][0] = *(const u32x4*)(row_ + s * 1024); xr[j][s][1] = *(const u32x4*)(row_ + s * 1024 + 8); } } \
        abw = (unsigned)proj[(size_t)n2_ * DINP + C_AL + h2_] | ((unsigned)proj[(size_t)n2_ * DINP + C_BE + h2_] << 16); } while (0)
    if (ubeg < uend) { int tid0 = F.tid; asm volatile("" : "+v"(tid0)); DN_PREFETCH(ubeg, tid0); }
    for (int uo = ubeg; uo < uend; ++uo) {
        const int h = uo >> 8, c = uo & 63, b = (uo >> 6) & 3, unit = (b << 9) | (h << 6) | c, t0 = b * SEQ + c * 64;
        int tid = F.tid; asm volatile("" : "+v"(tid));
        const int r = tid & 15, q = (tid >> 4) & 3, w = __builtin_amdgcn_readfirstlane(tid >> 6), lane = tid & 63;
        LAS bf16* QN = (LAS bf16*)(F.lds + DNL_QN); LAS bf16* KN = (LAS bf16*)(F.lds + DNL_KN); LAS bf16* VT = (LAS bf16*)(F.lds + DNL_VT); LAS bf16* KT = (LAS bf16*)(F.lds + DNL_KT);
        LAS bf16* KDT = (LAS bf16*)(F.lds + DNL_KDT); LAS float* LM = (LAS float*)(F.lds + DNL_LM); LAS bf16* AT = (LAS bf16*)(F.lds + DNL_AT); LAS float* gsh = (LAS float*)(F.lds + DNL_SM);
        asm volatile("" : "+v"(QN), "+v"(KN), "+v"(VT), "+v"(KT), "+v"(KDT), "+v"(LM), "+v"(AT), "+v"(gsh));
        LAS float* bsh = gsh + 64; LAS float* gcs = gsh + 128; LAS float* egc = gsh + 192;
        LAS float* CW = (LAS float*)(F.lds + DNL_CW); asm volatile("" : "+v"(CW));
        __syncthreads();
        if (h != hcur) { hcur = h;
            for (int i = tid; i < 4 * 3 * 32; i += NTHR) { const int j = i / 96, s2 = (i / 32) % 3, c4 = i & 31;
                *(LAS f32x4*)(CW + (j * 3 + s2) * 128 + 4 * c4) = *(const f32x4*)(A.in[IN_CONVW] + (size_t)(layer * 4 + j) * 3072 + s2 * 1024 + h * 128 + 4 * c4); }
            __syncthreads(); }
        const int t = tid >> 3, sub = tid & 7, n = t0 + t;
        const int tsw = (((t >> 3) ^ sub) << 3) | (t & 7);
        float kn[16];
        {
            float a[3][16];
            {
            f32x2p a2[3][8];
#pragma unroll
            for (int s = 0; s < 3; ++s)
#pragma unroll
                for (int k = 0; k < 8; ++k) a2[s][k] = (f32x2p){0.f, 0.f};
            {
                unsigned km[4];
#pragma unroll
                for (int j = 0; j < 4; ++j) km[j] = (c * 64 + t - 3 + j) >= 0 ? 0xffffffffu : 0u;
#pragma unroll
                for (int j = 0; j < 4; ++j)
#pragma unroll
                    for (int s = 0; s < 3; ++s) { asm volatile("" ::: "memory");
                        const LAS float* cw = CW + (j * 3 + s) * 128 + 16 * sub; const u32x4 x0 = xr[j][s][0] & km[j], x1 = xr[j][s][1] & km[j];
                        const f32x4 w0 = *(const LAS f32x4*)cw, w1 = *(const LAS f32x4*)(cw + 4), w2 = *(const LAS f32x4*)(cw + 8), w3 = *(const LAS f32x4*)(cw + 12);
                        dn_pkfma(a2[s][0], (f32x2p){bflo(x0.x), bfhi(x0.x)}, __builtin_shufflevector(w0, w0, 0, 1)); dn_pkfma(a2[s][1], (f32x2p){bflo(x0.y), bfhi(x0.y)}, __builtin_shufflevector(w0, w0, 2, 3));
                        dn_pkfma(a2[s][2], (f32x2p){bflo(x0.z), bfhi(x0.z)}, __builtin_shufflevector(w1, w1, 0, 1)); dn_pkfma(a2[s][3], (f32x2p){bflo(x0.w), bfhi(x0.w)}, __builtin_shufflevector(w1, w1, 2, 3));
                        dn_pkfma(a2[s][4], (f32x2p){bflo(x1.x), bfhi(x1.x)}, __builtin_shufflevector(w2, w2, 0, 1)); dn_pkfma(a2[s][5], (f32x2p){bflo(x1.y), bfhi(x1.y)}, __builtin_shufflevector(w2, w2, 2, 3));
                        dn_pkfma(a2[s][6], (f32x2p){bflo(x1.z), bfhi(x1.z)}, __builtin_shufflevector(w3, w3, 0, 1)); dn_pkfma(a2[s][7], (f32x2p){bflo(x1.w), bfhi(x1.w)}, __builtin_shufflevector(w3, w3, 2, 3)); }
                asm volatile("" ::: "memory"); }
#pragma unroll
            for (int s = 0; s < 3; ++s)
#pragma unroll
                for (int k = 0; k < 16; ++k) a[s][k] = a2[s][k >> 1][k & 1];
            }
            const unsigned abcur = abw;
            DN_PREFETCH(uo + 1, tid);
            float sq = 0.f, sk = 0.f;
#pragma unroll
            for (int k = 0; k < 16; ++k) { a[0][k] = siluf(a[0][k]); a[1][k] = siluf(a[1][k]); a[2][k] = siluf(a[2][k]); sq += a[0][k] * a[0][k]; sk += a[1][k] * a[1][k]; }
            sq += __shfl_xor(sq, 1); sq += __shfl_xor(sq, 2); sq += __shfl_xor(sq, 4); sk += __shfl_xor(sk, 1); sk += __shfl_xor(sk, 2); sk += __shfl_xor(sk, 4);
            const float rq = rsqrtf(sq + EPS) * 0.08838834764831845f, rk = rsqrtf(sk + EPS);
            u32x4 qa, qb, ka, kb;
#pragma unroll
            for (int k = 0; k < 16; ++k) { a[0][k] *= rq; kn[k] = a[1][k] * rk; }
            qa.x = pk2(a[0][0], a[0][1]); qa.y = pk2(a[0][2], a[0][3]); qa.z = pk2(a[0][4], a[0][5]); qa.w = pk2(a[0][6], a[0][7]);
            qb.x = pk2(a[0][8], a[0][9]); qb.y = pk2(a[0][10], a[0][11]); qb.z = pk2(a[0][12], a[0][13]); qb.w = pk2(a[0][14], a[0][15]);
            ka.x = pk2(kn[0], kn[1]); ka.y = pk2(kn[2], kn[3]); ka.z = pk2(kn[4], kn[5]); ka.w = pk2(kn[6], kn[7]);
            kb.x = pk2(kn[8], kn[9]); kb.y = pk2(kn[10], kn[11]); kb.z = pk2(kn[12], kn[13]); kb.w = pk2(kn[14], kn[15]);
            *(LAS u32x4*)(QN + t * DN_RS + 16 * sub) = qa; *(LAS u32x4*)(QN + t * DN_RS + 16 * sub + 8) = qb;
            *(LAS u32x4*)(KN + t * DN_RS + 16 * sub) = ka; *(LAS u32x4*)(KN + t * DN_RS + 16 * sub + 8) = kb;
#pragma unroll
            for (int k = 0; k < 16; ++k) { KT[(16 * sub + k) * DN_TS + tsw] = (bf16)f2bf(kn[k]); VT[(16 * sub + k) * DN_TS + tsw] = (bf16)f2bf(a[2][k]); }
            if (sub == 0) { const float al = bflo(abcur), be = bfhi(abcur);
                gsh[t] = -expf(A.in[IN_ALOG][layer * 8 + h]) * softplusf_(al + A.in[IN_DTB][layer * 8 + h]); bsh[t] = sigmoidf_(be); }
        }
        __syncthreads();
        if (w == 0) { float v = gsh[lane];
#pragma unroll
            for (int o = 1; o < 64; o <<= 1) { const float nb = __shfl_up(v, o); if (lane >= o) v += nb; }
            gcs[lane] = v; egc[lane] = __expf(v);
            if (lane == 63) ((float*)(F.ws + WS_DNEG))[unit] = __expf(v); }
        __syncthreads();
        { const float sc = __expf(gcs[63] - gcs[t]);
#pragma unroll
          for (int k = 0; k < 16; ++k) KDT[(16 * sub + k) * DN_TS + tsw] = (bf16)f2bf(kn[k] * sc); }
        _Pragma("unroll 1") for (int rep3_ = 0; rep3_ < REP_DN3; ++rep3_)
        { const int mat = w >> 2, mt = w & 3; const LAS bf16* Am = mat ? QN : KN;
          bf16x8 af[4];
#pragma unroll
          for (int ks = 0; ks < 4; ++ks) af[ks] = *(const LAS bf16x8*)(Am + (16 * mt + r) * DN_RS + 32 * ks + 8 * q);
#pragma unroll
          for (int nt = 0; nt < 4; ++nt) { f32x4 d = (f32x4){0.f, 0.f, 0.f, 0.f};
#pragma unroll
              for (int ks = 0; ks < 4; ++ks) { const bf16x8 bfr = *(const LAS bf16x8*)(KN + (16 * nt + r) * DN_RS + 32 * ks + 8 * q); d = __builtin_amdgcn_mfma_f32_16x16x32_bf16(af[ks], bfr, d, 0, 0, 0); }
              const int j = 16 * nt + r; const float gj = gcs[j];
#pragma unroll
              for (int ii = 0; ii < 4; ++ii) { const int i = 16 * mt + 4 * q + ii; const float dec = (i >= j) ? __expf(gcs[i] - gj) : 0.f;
                  if (mat == 0) LM[i * DN_LS + j] = (i > j) ? bsh[i] * d[ii] * dec : 0.f; else AT[i * DN_TS + j] = (bf16)f2bf(d[ii] * dec); } } }
        __syncthreads();
        {
            const int col = tid >> 1, par = tid & 1, d = col & 127; const bool isw = col >= 128; LAS bf16* rowp = (isw ? KT : VT) + d * DN_TS + 4 * par; const int sd = d >> 4;
            f32x2p xp[16];
            _Pragma("unroll 1") for (int rep4_ = 0; rep4_ < REP_DN4; ++rep4_) {
#pragma unroll
            for (int g = 0; g < 8; ++g) { const u32x2 v = *(const LAS u32x2*)(rowp + 8 * (g ^ sd));
                const f32x4 bb = *(const LAS f32x4*)(bsh + 8 * g + 4 * par), ee = *(const LAS f32x4*)(egc + 8 * g + 4 * par);
                xp[2 * g] = (f32x2p){bflo(v.x) * bb[0] * (isw ? ee[0] : 1.0f), bfhi(v.x) * bb[1] * (isw ? ee[1] : 1.0f)};
                xp[2 * g + 1] = (f32x2p){bflo(v.y) * bb[2] * (isw ? ee[2] : 1.0f), bfhi(v.y) * bb[3] * (isw ? ee[3] : 1.0f)}; }
            DnSolveRow<63>::run(xp, LM + 4 * par, par);
            if (rep4_ == REP_DN4 - 1) {
#pragma unroll
            for (int g = 0; g < 8; ++g) { u32x2 v; v.x = pk2(xp[2 * g][0], xp[2 * g][1]); v.y = pk2(xp[2 * g + 1][0], xp[2 * g + 1][1]); *(LAS u32x2*)(rowp + 8 * (g ^ sd)) = v; } } }
        }
        __syncthreads();
        _Pragma("unroll 1") for (int rep5_ = 0; rep5_ < REP_DN5; ++rep5_)
        { const LAS bf16* UT = VT; const LAS bf16* WT = KT;
          bf16* gW = (bf16*)(F.ws + WS_DNW) + (size_t)unit * 16384; bf16* gN = (bf16*)(F.ws + WS_DNN) + (size_t)unit * 16384;
          bf16* gQ = (bf16*)(F.ws + WS_DNQ) + (size_t)unit * 8192; bf16* gO = (bf16*)(F.ws + WS_DNOL) + (size_t)unit * 8192;
          const int p2 = w >> 1, hh = w & 1;
          bf16x8 wf2[2][2], uf[2], kf[2];
#pragma unroll
          for (int ks = 0; ks < 2; ++ks) {
#pragma unroll
              for (int tl = 0; tl < 2; ++tl) wf2[tl][ks] = *(const LAS bf16x8*)(WT + (16 * (2 * p2 + tl) + r) * DN_TS + 8 * ((4 * ks + q) ^ (2 * p2 + tl)));
              uf[ks] = *(const LAS bf16x8*)(UT + (16 * w + r) * DN_TS + 8 * ((4 * ks + q) ^ w)); kf[ks] = *(const LAS bf16x8*)(KDT + (16 * w + r) * DN_TS + 8 * ((4 * ks + q) ^ w)); }
#pragma unroll
          for (int n4 = 0; n4 < 4; ++n4) { const int nt = 4 * hh + n4; f32x4 d0 = (f32x4){0.f, 0.f, 0.f, 0.f}, d1 = (f32x4){0.f, 0.f, 0.f, 0.f};
#pragma unroll
              for (int ks = 0; ks < 2; ++ks) { const bf16x8 bfr = *(const LAS bf16x8*)(KDT + (16 * nt + r) * DN_TS + 8 * ((4 * ks + q) ^ nt));
                  d0 = __builtin_amdgcn_mfma_f32_16x16x32_bf16(wf2[0][ks], bfr, d0, 0, 0, 0); d1 = __builtin_amdgcn_mfma_f32_16x16x32_bf16(wf2[1][ks], bfr, d1, 0, 0, 0); }
              u32x4 o; o.x = pk2(-d0[0], -d0[1]); o.y = pk2(-d0[2], -d0[3]); o.z = pk2(-d1[0], -d1[1]); o.w = pk2(-d1[2], -d1[3]);
              if (FAKE != 2) *(u32x4*)(gW + (size_t)(((nt * 4 + p2) * 64 + lane) * 8)) = o; }
#pragma unroll
          for (int nt = 0; nt < 8; ++nt) { f32x4 d = (f32x4){0.f, 0.f, 0.f, 0.f};
#pragma unroll
              for (int ks = 0; ks < 2; ++ks) { const bf16x8 bfr = *(const LAS bf16x8*)(UT + (16 * nt + r) * DN_TS + 8 * ((4 * ks + q) ^ nt)); d = __builtin_amdgcn_mfma_f32_16x16x32_bf16(kf[ks], bfr, d, 0, 0, 0); }
              u32x2 o; o.x = pk2(d[0], d[1]); o.y = pk2(d[2], d[3]); if (FAKE != 2) *(u32x2*)(gN + (size_t)(((nt * 8 + w) * 64 + lane) * 4)) = o; }
#pragma unroll
          for (int n2 = 0; n2 < 2; ++n2) { const int nt = 2 * hh + n2; f32x4 d0 = (f32x4){0.f, 0.f, 0.f, 0.f}, d1 = (f32x4){0.f, 0.f, 0.f, 0.f};
#pragma unroll
              for (int ks = 0; ks < 2; ++ks) { const bf16x8 bfr = *(const LAS bf16x8*)(AT + (16 * nt + r) * DN_TS + 32 * ks + 8 * q);
                  d0 = __builtin_amdgcn_mfma_f32_16x16x32_bf16(wf2[0][ks], bfr, d0, 0, 0, 0); d1 = __builtin_amdgcn_mfma_f32_16x16x32_bf16(wf2[1][ks], bfr, d1, 0, 0, 0); }
              const int tt = 16 * nt + r; const float eg = egc[tt]; const u32x2 qa = *(const LAS u32x2*)(QN + tt * DN_RS + 32 * p2 + 4 * q), qb = *(const LAS u32x2*)(QN + tt * DN_RS + 32 * p2 + 16 + 4 * q);
              u32x4 o; o.x = pk2(bflo(qa.x) * eg - d0[0], bfhi(qa.x) * eg - d0[1]); o.y = pk2(bflo(qa.y) * eg - d0[2], bfhi(qa.y) * eg - d0[3]);
              o.z = pk2(bflo(qb.x) * eg - d1[0], bfhi(qb.x) * eg - d1[1]); o.w = pk2(bflo(qb.y) * eg - d1[2], bfhi(qb.y) * eg - d1[3]);
              if (FAKE != 2) *(u32x4*)(gQ + (size_t)(((nt * 4 + p2) * 64 + lane) * 8)) = o; }
#pragma unroll
          for (int nt = 0; nt < 4; ++nt) { f32x4 e = (f32x4){0.f, 0.f, 0.f, 0.f};
#pragma unroll
              for (int ks = 0; ks < 2; ++ks) { const bf16x8 bfr = *(const LAS bf16x8*)(AT + (16 * nt + r) * DN_TS + 32 * ks + 8 * q); e = __builtin_amdgcn_mfma_f32_16x16x32_bf16(uf[ks], bfr, e, 0, 0, 0); }
              u32x2 p; p.x = pk2(e[0], e[1]); p.y = pk2(e[2], e[3]); if (FAKE != 2) *(u32x2*)(gO + (size_t)(((nt * 8 + w) * 64 + lane) * 4)) = p; }
        }
    }
}
constexpr int DN_PF = 8;
template <int MODE = 0> __device__ __forceinline__ void dn_scan_coop(const Args& A, const Frame& F, int tsk) {
    const int r = F.lane & 15, q = F.lane >> 4, w = F.wave, sl = (tsk >> 3) & 7, bh = 4 * (tsk & 7) + (tsk >> 6);
    LAS unsigned char* SF = F.lds;
    const float* egp = (const float*)(F.ws + WS_DNEG) + (size_t)bh * 64;
    const bf16* gW0 = (const bf16*)(F.ws + WS_DNW) + (size_t)bh * 64 * 16384 + (size_t)((w * 4) * 64 + F.lane) * 8;
    const bf16* gN0 = (const bf16*)(F.ws + WS_DNN) + (size_t)bh * 64 * 16384 + (size_t)((sl * 8 + w) * 64 + F.lane) * 4;
    unsigned char* gS1 = F.ws + WS_DNS + ((size_t)bh * 64 * 8 + sl) * 4096 + (size_t)(64 * (w & 3) + F.lane) * 16;
    f32x4 acc = (f32x4){0.f, 0.f, 0.f, 0.f};
    bf16x8 wf[DN_PF][4]; u32x2 nw[DN_PF];
    const float egv = egp[F.lane];
#pragma unroll
    for (int d = 0; d < DN_PF; ++d) {
#pragma unroll
        for (int ks = 0; ks < 4; ++ks) wf[d][ks] = *(const bf16x8*)(gW0 + (size_t)d * 16384 + 512 * ks);
        nw[d] = *(const u32x2*)(gN0 + (size_t)d * 16384); }
#ifdef SCAN_ROLLED
#pragma unroll 1
    for (int c0 = 0; c0 < NCHUNK; c0 += 2 * DN_PF) {
#pragma unroll
        for (int dd = 0; dd < 2 * DN_PF; ++dd) { const int d = dd % DN_PF, c = c0 + dd;
#else
#pragma unroll
    for (int c0 = 0; c0 < NCHUNK; c0 += DN_PF) {
#pragma unroll
        for (int d = 0; d < DN_PF; ++d) { const int c = c0 + d;
#endif
            u32x2 v; v.x = pk2(acc[0], acc[1]); v.y = pk2(acc[2], acc[3]);
            *(LAS u32x2*)(SF + ((c & 1) * 4 + (w >> 1)) * 1024 + F.lane * 16 + 8 * (w & 1)) = v;
            __syncthreads();
            bf16x8 sf[4];
#pragma unroll
            for (int ks = 0; ks < 4; ++ks) sf[ks] = *(const LAS bf16x8*)(SF + ((c & 1) * 4 + ks) * 1024 + F.lane * 16);
            if (MODE == 0 && w < 4) { const u32x4 sw = *(const LAS u32x4*)(SF + ((c & 1) * 4 + w) * 1024 + F.lane * 16); *(u32x4*)(gS1 + (size_t)c * 8 * 4096) = sw; }
            const float e = __builtin_bit_cast(float, __builtin_amdgcn_readlane(__builtin_bit_cast(int, egv), c));
            acc[0] = acc[0] * e + bflo(nw[d].x); acc[1] = acc[1] * e + bfhi(nw[d].x); acc[2] = acc[2] * e + bflo(nw[d].y); acc[3] = acc[3] * e + bfhi(nw[d].y);
#pragma unroll
            for (int ks = 0; ks < 4; ++ks) acc = __builtin_amdgcn_mfma_f32_16x16x32_bf16(wf[d][ks], sf[ks], acc, 0, 0, 0);
            { const int cn = MODE == 1 ? 0 : (c + DN_PF < NCHUNK ? c + DN_PF : NCHUNK - 1);
#pragma unroll
                for (int ks = 0; ks < 4; ++ks) wf[d][ks] = *(const bf16x8*)(gW0 + (size_t)cn * 16384 + 512 * ks);
                nw[d] = *(const u32x2*)(gN0 + (size_t)cn * 16384); }
        }
    }
}
__device__ __forceinline__ void dn_out(const Args& A, const Frame& F, int layer) {
    const bf16* proj = (const bf16*)(F.ws + WS_PROJ); bf16* mc = (bf16*)(F.ws + WS_MIXCAT);
    const int r = F.lane & 15, q = F.lane >> 4;
    for (int task = F.gw; task < NBATCH * 8 * NCHUNK * 4; task += F.ngw) {
        const int unit = task >> 2, mt = task & 3, c = unit & 63, h = (unit >> 6) & 7, b = unit >> 9, tok = b * SEQ + c * 64 + 16 * mt + r;
        const bf16* gQ = (const bf16*)(F.ws + WS_DNQ) + (size_t)unit * 8192 + (size_t)((mt * 4) * 64 + F.lane) * 8; const bf16* gO = (const bf16*)(F.ws + WS_DNOL) + (size_t)unit * 8192 + (size_t)((mt * 8) * 64 + F.lane) * 4;
        const u32x4* gS = (const u32x4*)(F.ws + WS_DNS) + (size_t)unit * 8 * 256 + F.lane;
        bf16x8 qf[4];
#pragma unroll
        for (int ks = 0; ks < 4; ++ks) qf[ks] = *(const bf16x8*)(gQ + 512 * ks);
        u32x4 sv[32]; u32x2 ow[8], gwv[8];
#pragma unroll
        for (int i = 0; i < 32; ++i) sv[i] = gS[i * 64];
#pragma unroll
        for (int sl = 0; sl < 8; ++sl) { ow[sl] = *(const u32x2*)(gO + 256 * sl); gwv[sl] = *(const u32x2*)(proj + (size_t)tok * DINP + C_GATE + h * 128 + 16 * sl + 4 * q); }
        f32x4 o[8]; float ss = 0.f;
#pragma unroll
        for (int sl = 0; sl < 8; ++sl) { o[sl] = (f32x4){bflo(ow[sl].x), bfhi(ow[sl].x), bflo(ow[sl].y), bfhi(ow[sl].y)};
#pragma unroll
            for (int ks = 0; ks < 4; ++ks) o[sl] = __builtin_amdgcn_mfma_f32_16x16x32_bf16(__builtin_bit_cast(bf16x8, sv[sl * 4 + ks]), qf[ks], o[sl], 0, 0, 0);
            ss += (o[sl][0] * o[sl][0] + o[sl][1] * o[sl][1]) + (o[sl][2] * o[sl][2] + o[sl][3] * o[sl][3]); }
        ss += __shfl_xor(ss, 16); ss += __shfl_xor(ss, 32);
        const float rs = rsqrtf(ss * (1.0f / 128.0f) + EPS);
#pragma unroll
        for (int sl = 0; sl < 8; ++sl) { const f32x4 an = *(const f32x4*)(A.in[IN_ANORM] + layer * 128 + 16 * sl + 4 * q); const u32x2 gw = gwv[sl];
            u32x2 w; w.x = pk2(o[sl][0] * rs * an[0] * siluf(bflo(gw.x)), o[sl][1] * rs * an[1] * siluf(bfhi(gw.x))); w.y = pk2(o[sl][2] * rs * an[2] * siluf(bflo(gw.y)), o[sl][3] * rs * an[3] * siluf(bfhi(gw.y)));
            *(u32x2*)(mc + (size_t)tok * DM + h * 128 + 16 * sl + 4 * q) = w; }
    }
}
#ifndef MULTI_LAUNCH
#define MULTI_LAUNCH 1
#endif
#ifndef NAIVE_DN
#define NAIVE_DN 1
#endif
#ifndef NAIVE_SWA
#define NAIVE_SWA 1
#endif
#ifndef NAIVE_S5
#define NAIVE_S5 1
#endif

#ifndef USE_NAIVE_DN
#define USE_NAIVE_DN 1
#endif
#ifndef USE_NAIVE_SWA
#define USE_NAIVE_SWA 1
#endif
#ifndef USE_NAIVE_S5
#define USE_NAIVE_S5 1
#endif

__device__ __forceinline__ void site_gemm_store(LAS unsigned char* lds, const bf16* Amat, const bf16* Bt, int nM, int nN, int K, const int* tile_e, bf16* O, int ldc, int G, int bid) {
    pg8::Gemm g{Amat, Bt, nM * 256, nN * 256, K}; pg8::ExpertOrder S; S.init(nM, nN, G, bid, tile_e);
    pg8::EpiStore E{O, ldc}; pg8::gemm_phase<pg8::EpiStore, pg8::ExpertOrder, true, true>(lds, g, S, E);
}
__device__ __forceinline__ void site_gemm_swiglu(LAS unsigned char* lds, const bf16* Amat, const bf16* Bt, int nM, int nN, int K, const int* tile_e, bf16* O, int ldc, int G, int bid) {
    pg8::Gemm g{Amat, Bt, nM * 256, nN * 256, K}; pg8::ExpertOrder S; S.init(nM, nN, G, bid, tile_e);
    pg8::EpiSwiGLU E{O, ldc}; pg8::gemm_phase<pg8::EpiSwiGLU, pg8::ExpertOrder, true, true>(lds, g, S, E);
}
__device__ __forceinline__ void site_gemm_glu(LAS unsigned char* lds, const bf16* Amat, const bf16* Bt, int nM, int nN, int K, bf16* O, const float* bias, int ldc, int G, int bid) {
    pg8::Gemm g{Amat, Bt, nM * 256, nN * 256, K}; pg8::ExpertOrder S; S.init(nM, nN, G, bid, nullptr);
    pg8::EpiGLU E{O, Amat, bias, ldc}; pg8::gemm_phase<pg8::EpiGLU, pg8::ExpertOrder, true, true>(lds, g, S, E);
}
__device__ __forceinline__ void site_gemm_swiglu8(LAS unsigned char* lds, const bf16* Amat, const bf16* Bt, int nM, int nN, int Kh, const int* tile_e, unsigned char* O, int ldc, int G, int bid) {
    pg8::Gemm g{Amat, Bt, nM * 256, nN * 256, Kh}; pg8::ExpertOrder S; S.init(nM, nN, G, bid, tile_e);
    pg8::EpiSwiGLU8 E{O, ldc, 1.0f / (F8_SA * F8_SW), F8_SH}; pg8::gemm_phase<pg8::EpiSwiGLU8, pg8::ExpertOrder, true, true, true>(lds, g, S, E);
}
__device__ __forceinline__ void site_gemm_store8(LAS unsigned char* lds, const bf16* Amat, const bf16* Bt, int nM, int nN, int Kh, const int* tile_e, bf16* O, int ldc, int G, int bid) {
    pg8::Gemm g{Amat, Bt, nM * 256, nN * 256, Kh}; pg8::ExpertOrder S; S.init(nM, nN, G, bid, tile_e);
    pg8::EpiStoreScaled E{O, ldc, 1.0f / (F8_SH * F8_SW)}; pg8::gemm_phase<pg8::EpiStoreScaled, pg8::ExpertOrder, true, true, true>(lds, g, S, E);
}
__device__ __forceinline__ void site_gemm_store8_split(LAS unsigned char* lds, const bf16* Amat, const bf16* Bt, int nM, int nN, int Kh, const int* tile_e, bf16* O, float* Pp, int ldc, int G, int bid) {
    pg8::Gemm g{Amat, Bt, nM * 256, nN * 256, Kh}; pg8::ExpertOrderSplit S; S.init(nM, nN, YP_NF, G, bid, tile_e);
    pg8::EpiStoreScaledSplit E{O, Pp, ldc, 1.0f / (F8_SH * F8_SW), YP_NF, YP_SLICE}; pg8::gemm_phase<pg8::EpiStoreScaledSplit, pg8::ExpertOrderSplit, true, true, true>(lds, g, S, E);
}
__device__ __forceinline__ void site_gemm_swiglu_i8(LAS unsigned char* lds, const bf16* Amat, const bf16* Bt, int nM, int nN, int Kh, bf16* O, int ldc, const float* rowscale, const unsigned* wmax, int G, int bid) {
    pg8::Gemm g{Amat, Bt, nM * 256, nN * 256, Kh}; pg8::ExpertOrder S; S.init(nM, nN, G, bid, nullptr);
    pg8::EpiSwiGLUi8 E{O, ldc, rowscale, wmax}; pg8::gemm_phase<pg8::EpiSwiGLUi8, pg8::ExpertOrder, true, true, false, true>(lds, g, S, E);
}
__device__ __forceinline__ void site_gemm_store_i8(LAS unsigned char* lds, const bf16* Amat, const bf16* Bt, int nM, int nN, int Kh, bf16* O, int ldc, const float* rowscale, const unsigned* wmax, int G, int bid) {
    pg8::Gemm g{Amat, Bt, nM * 256, nN * 256, Kh}; pg8::ExpertOrder S; S.init(nM, nN, G, bid, nullptr);
    pg8::EpiStoreI8 E{O, ldc, rowscale, wmax}; pg8::gemm_phase<pg8::EpiStoreI8, pg8::ExpertOrder, true, true, false, true>(lds, g, S, E);
}
extern __shared__ __attribute__((aligned(16))) unsigned char lds_raw[];
__device__ __forceinline__ void fresh(const Args& A, Frame& F) {
    long zoff = 0; asm volatile("" : "+s"(zoff));
    unsigned char* ws = A.ws + zoff; float* out = A.out + zoff;
    int tid = threadIdx.x; asm volatile("" : "+v"(tid));
    F.lds = (LAS unsigned char*)lds_raw;
    F.tid = tid; F.lane = tid & 63; F.wave = __builtin_amdgcn_readfirstlane(tid >> 6); F.G = gridDim.x; F.bid = blockIdx.x;
    F.gw = F.bid * NWAVES + F.wave; F.ngw = F.G * NWAVES; F.gt = F.bid * NTHR + tid; F.ngt = F.G * NTHR;
    F.out = out; F.ws = ws;
}
__device__ __forceinline__ void grid_bar(const Args& A) {
    long zoff = 0; asm volatile("" : "+s"(zoff));
    unsigned char* ws = A.ws + zoff;
    XcdBarrier b; b.bar = (unsigned*)(ws + WS_CTL) + CW_BAR; b.x = xb_xcc_id(); b.st = (volatile LAS unsigned*)((LAS unsigned char*)lds_raw + LDS_MISC) + 8;
#ifdef REP_BAR
    xcd_barrier(b);
#endif
    xcd_barrier(b);
}
#define PH_BEGIN Frame F; fresh(A, F); const Args& P = A; (void)P;
#define WSP(off) ((bf16*)(F.ws + (off)))
#ifndef REP_P0W
#define REP_P0W 1
#endif
#ifndef REP_P0T
#define REP_P0T 1
#endif
#ifndef REP_P0N
#define REP_P0N 1
#endif
__device__ __forceinline__ void ph_p0(const Args& A) {
    _Pragma("unroll 1") for (int rep_ = 0; rep_ < REP_P0W; ++rep_) { PH_BEGIN p0_weights(P, F); }
    _Pragma("unroll 1") for (int rep_ = 0; rep_ < REP_P0T; ++rep_) { PH_BEGIN p0_s5tab(P, F); }
    _Pragma("unroll 1") for (int rep_ = 0; rep_ < REP_P0N; ++rep_) { PH_BEGIN rp_norm1(P, F, P.in[IN_X], P.in[IN_LNG], WSP(WS_HN)); }
    if (USE_I8) { PH_BEGIN __syncthreads(); p0_i8_strips(P, F); } }
template <int layer> __device__ __forceinline__ void ph_win(const Args& A) { PH_BEGIN
    if (USE_I8_WIN) site_gemm_store_i8(F.lds, WSP(WS_HN), WSP(WS_WIN + layer * WIN_BYTES), NTOK / 256, DINP / 256, DM / 2, WSP(WS_PROJ), DINP, (const float*)(F.ws + WS_MISC) + MI_ROWSC, (const unsigned*)(F.ws + WS_CTL) + CW_COLMAX + layer * DINP, F.G, F.bid);
    else site_gemm_store(F.lds, WSP(WS_HN), WSP(WS_WIN + layer * WIN_BYTES), NTOK / 256, DINP / 256, DM, nullptr, WSP(WS_PROJ), DINP, F.G, F.bid); }
template <int layer> __device__ __forceinline__ void ph_dnprep_n(const Args& A) { PH_BEGIN dn_prep_naive(P, F, layer); }
template <int layer> __device__ __forceinline__ void ph_dnscan_n(const Args& A) { PH_BEGIN if (F.wave == 0 && F.bid < 128) dn_scan_naive(P, F, F.bid); }
template <int layer> __device__ __forceinline__ void ph_dnfin_n(const Args& A) { PH_BEGIN dn_finalize_naive(P, F, layer); }
template <int layer> __device__ __forceinline__ void ph_swa_n(const Args& A) { PH_BEGIN swa_naive(P, F, layer); }
template <int layer> __device__ __forceinline__ void ph_s5scan_n(const Args& A) { PH_BEGIN if (F.wave == 0 && F.bid >= 128) s5_scan_naive(P, F, layer, F.bid - 128); }
template <int layer> __device__ __forceinline__ void ph_s5out_n(const Args& A) { PH_BEGIN s5_out_naive(P, F, layer); }
template <int layer> __device__ __forceinline__ void ph_dnprep(const Args& A) { PH_BEGIN dn_chunk_prep(P, F, layer); }
#ifdef DN_FAKE
template <int layer> __device__ __forceinline__ void ph_dnprep_fake(const Args& A) { PH_BEGIN dn_chunk_prep<DN_FAKE>(P, F, layer); }
#endif
template <int layer> __device__ __forceinline__ void ph_dnscan(const Args& A) { PH_BEGIN for (int tsk = F.bid; tsk < 256; tsk += F.G) { __syncthreads(); dn_scan_coop(P, F, tsk); } }
template <int layer> __device__ __forceinline__ void ph_dnout(const Args& A) { PH_BEGIN dn_out(P, F, layer); }
template <int layer> __device__ __forceinline__ void ph_swa(const Args& A) { PH_BEGIN swa_mfma(P, F, layer); }
template <int layer> __device__ __forceinline__ void ph_s5a(const Args& A) { PH_BEGIN s5_chunk<false>(P, F, layer, F.gw, F.ngw); }
template <int layer> __device__ __forceinline__ void ph_s5b(const Args& A) { PH_BEGIN s5_chunk<true>(P, F, layer, F.gw, F.ngw); }
#ifndef REP_SCAN
#define REP_SCAN 1
#endif
#ifndef REP_S5B
#define REP_S5B 1
#endif
template <int layer> __device__ __forceinline__ void ph_scan_s5b(const Args& A) {
#ifdef SCAN_PROBE
    { PH_BEGIN for (int tsk = F.bid; tsk < 256; tsk += F.G) { __syncthreads(); dn_scan_coop<SCAN_PROBE>(P, F, tsk); } __syncthreads(); }
#endif
    _Pragma("unroll 1") for (int rep_ = 0; rep_ < REP_SCAN; ++rep_) { PH_BEGIN for (int tsk = F.bid; tsk < 256; tsk += F.G) { __syncthreads(); dn_scan_coop(P, F, tsk); } __syncthreads(); }
    _Pragma("unroll 1") for (int rep_ = 0; rep_ < REP_S5B; ++rep_) { PH_BEGIN s5_chunk<true>(P, F, layer, F.gw, F.ngw); } }
template <int layer> __device__ __forceinline__ void ph_glu(const Args& A) { PH_BEGIN site_gemm_glu(F.lds, WSP(WS_Z), WSP(WS_WGLU + layer * WGLU_BYTES), NTOK / 256, 2, 512, WSP(WS_GLU), P.in[IN_BGLU] + layer * 512, 512, F.G, F.bid); }
template <int layer> __device__ __forceinline__ void ph_bcfin(const Args& A) { PH_BEGIN bc_finalize(P, F, layer, NAIVE_SWA != 0, true); }
template <int layer> __device__ __forceinline__ void ph_wout(const Args& A) { PH_BEGIN site_gemm_store(F.lds, WSP(WS_MIXCAT), WSP(WS_WOUT + layer * WOUT_BYTES), NTOK / 256, DM / 256, DM, nullptr, WSP(WS_MIXOUT), DM, F.G, F.bid); }
template <int layer> __device__ __forceinline__ void ph_postmix(const Args& A) { PH_BEGIN const float* gains = P.in[IN_LNG] + (size_t)layer * 4 * DM;
    rp_post_mixer(P, F, layer == 0 ? P.in[IN_X] : F.out, WSP(WS_MIXOUT), gains + DM, gains + 2 * DM, WSP(WS_HN), (layer & 1) != 0, P.in[IN_WR]); }
__device__ __forceinline__ void ph_dispatch(const Args& A) { PH_BEGIN moe_dispatch(P, F, WSP(WS_HN)); }
template <int layer> __device__ __forceinline__ void ph_gateup(const Args& A) { PH_BEGIN const int* misc = (const int*)(F.ws + WS_MISC);
    if (layer & 1) { if (USE_FP8) site_gemm_swiglu8(F.lds, WSP(WS_XG), WSP(WS_MGU), misc[MI_NTILES], 2 * DFF / 256, DM / 2, misc + MI_TILEE, F.ws + WS_HID, DFF, F.G, F.bid);
                     else site_gemm_swiglu(F.lds, WSP(WS_XG), WSP(WS_MGU), misc[MI_NTILES], 2 * DFF / 256, DM, misc + MI_TILEE, WSP(WS_HID), DFF, F.G, F.bid); }
    else { if (USE_FP8 && FP8_E0 == 0) site_gemm_swiglu8(F.lds, WSP(WS_HN), WSP(WS_FGU), NTOK / 256, 2 * DFF / 256, DM / 2, nullptr, F.ws + WS_HID, DFF, F.G, F.bid);
           else if (USE_I8) site_gemm_swiglu_i8(F.lds, WSP(WS_HN), WSP(WS_FGU), NTOK / 256, 2 * DFF / 256, DM / 2, WSP(WS_HID), DFF, (const float*)(F.ws + WS_MISC) + MI_ROWSC, (const unsigned*)(F.ws + WS_CTL) + CW_COLMAX + 2 * DINP, F.G, F.bid);
           else site_gemm_swiglu(F.lds, WSP(WS_HN), WSP(WS_FGU), NTOK / 256, 2 * DFF / 256, DM, nullptr, WSP(WS_HID), DFF, F.G, F.bid); } }
template <int layer> __device__ __forceinline__ void ph_down(const Args& A) { PH_BEGIN const int* misc = (const int*)(F.ws + WS_MISC);
    if (layer & 1) { if (USE_FP8) site_gemm_store8_split(F.lds, WSP(WS_HID), WSP(WS_MD), misc[MI_NTILES], DM / 256, DFF / 2, misc + MI_TILEE, WSP(WS_YG), (float*)(F.ws + WS_YP), DM, F.G, F.bid);
                     else site_gemm_store(F.lds, WSP(WS_HID), WSP(WS_MD), misc[MI_NTILES], DM / 256, DFF, misc + MI_TILEE, WSP(WS_YG), DM, F.G, F.bid); }
    else { if (USE_FP8 && FP8_E0 == 0) site_gemm_store8(F.lds, WSP(WS_HID), WSP(WS_FD), NTOK / 256, DM / 256, DFF / 2, nullptr, WSP(WS_YG), DM, F.G, F.bid);
           else site_gemm_store(F.lds, WSP(WS_HID), WSP(WS_FD), NTOK / 256, DM / 256, DFF, nullptr, WSP(WS_YG), DM, F.G, F.bid); } }
template <int layer> __device__ __forceinline__ void ph_postffn(const Args& A) { PH_BEGIN const float* gains = P.in[IN_LNG] + (size_t)layer * 4 * DM;
    rp_post_ffn(P, F, WSP(WS_YG), (layer & 1) != 0, gains + 3 * DM, layer == 0 ? P.in[IN_LNG] + 4 * DM : nullptr, WSP(WS_HN)); }

#if MULTI_LAUNCH
typedef void (*PhaseFn)(const Args&);
template <PhaseFn FN> __global__ void __launch_bounds__(NTHR, 2) kph(Args A) { FN(A); }
template <PhaseFn FN> static void launch_phase(const Args& a, int grid, hipStream_t stream) {
    static bool attr = false; if (!attr) { (void)hipFuncSetAttribute((const void*)kph<FN>, hipFuncAttributeMaxDynamicSharedMemorySize, LDS_BYTES); attr = true; }
    hipLaunchKernelGGL((kph<FN>), dim3(grid), dim3(NTHR), LDS_BYTES, stream, a);
}
template <int layer> static void launch_layer(const Args& a, int grid, hipStream_t stream) {
    launch_phase<ph_win<layer>>(a, grid, stream);
#if NAIVE_DN
    launch_phase<ph_dnprep_n<layer>>(a, grid, stream);
#else
    launch_phase<ph_dnprep<layer>>(a, grid, stream);
#endif
#if NAIVE_SWA
    launch_phase<ph_swa_n<layer>>(a, grid, stream);
#else
    launch_phase<ph_swa<layer>>(a, grid, stream);
#endif
#if NAIVE_S5
    launch_phase<ph_s5scan_n<layer>>(a, grid, stream); launch_phase<ph_s5out_n<layer>>(a, grid, stream);
#else
    launch_phase<ph_s5a<layer>>(a, grid, stream); launch_phase<ph_s5b<layer>>(a, grid, stream);
#endif
#if NAIVE_DN
    launch_phase<ph_dnscan_n<layer>>(a, grid, stream); launch_phase<ph_dnfin_n<layer>>(a, grid, stream);
#else
    launch_phase<ph_dnscan<layer>>(a, grid, stream); launch_phase<ph_dnout<layer>>(a, grid, stream);
#endif
    launch_phase<ph_glu<layer>>(a, grid, stream); launch_phase<ph_bcfin<layer>>(a, grid, stream); launch_phase<ph_wout<layer>>(a, grid, stream); launch_phase<ph_postmix<layer>>(a, grid, stream);
    if (layer & 1) launch_phase<ph_dispatch>(a, grid, stream);
    launch_phase<ph_gateup<layer>>(a, grid, stream); launch_phase<ph_down<layer>>(a, grid, stream); launch_phase<ph_postffn<layer>>(a, grid, stream);
}
static void launch_all(const Args& a, int grid, hipStream_t stream) { launch_phase<ph_p0>(a, grid, stream); launch_layer<0>(a, grid, stream); launch_layer<1>(a, grid, stream); }
#define MAIN_KERNEL kph<ph_p0>
#else
#ifndef REP_P0
#define REP_P0 1
#endif
#ifndef REP_PROJ
#define REP_PROJ 1
#endif
#ifndef REP_MIX
#define REP_MIX 1
#endif
#ifndef REP_FFN
#define REP_FFN 1
#endif
#ifndef REP_MIX1A
#define REP_MIX1A 1
#endif
#ifndef REP_MIX1B
#define REP_MIX1B 1
#endif
#ifndef REP_MIX1C
#define REP_MIX1C 1
#endif
#ifndef REP_MIX2
#define REP_MIX2 1
#endif
#ifndef REP_MIX3
#define REP_MIX3 1
#endif
#define REPEAT(n, stmt) do { _Pragma("unroll 1") for (int rep_ = 0; rep_ < (n); ++rep_) { stmt; } } while (0)
template <int layer> __device__ __forceinline__ void layer_body(const Args& A) {
    REPEAT(REP_PROJ, ph_win<layer>(A)); grid_bar(A);
#ifdef DN_FAKE
    ph_dnprep_fake<layer>(A);
#endif
    REPEAT(REP_MIX1A, ph_dnprep<layer>(A)); REPEAT(REP_MIX1B, ph_swa<layer>(A)); REPEAT(REP_MIX1C, ph_s5a<layer>(A)); grid_bar(A);
    REPEAT(REP_MIX2, ph_scan_s5b<layer>(A)); grid_bar(A);
    REPEAT(REP_MIX3, ph_glu<layer>(A); ph_dnout<layer>(A)); grid_bar(A); REPEAT(REP_MIX, ph_bcfin<layer>(A)); grid_bar(A); REPEAT(REP_PROJ, ph_wout<layer>(A)); grid_bar(A); ph_postmix<layer>(A); grid_bar(A);
    if (layer & 1) { ph_dispatch(A); grid_bar(A); }
    REPEAT(REP_FFN, ph_gateup<layer>(A)); grid_bar(A); REPEAT(REP_FFN, ph_down<layer>(A)); grid_bar(A); ph_postffn<layer>(A);
    if (layer == 0) grid_bar(A);
}
__global__ void __launch_bounds__(NTHR, 2) fwd_kernel(Args A) {
    { volatile LAS unsigned* MISC = (volatile LAS unsigned*)((LAS unsigned char*)lds_raw + LDS_MISC);
      if (threadIdx.x < 32) MISC[threadIdx.x] = 0u;
      __syncthreads();
      (void)xcd_barrier_post((unsigned*)(A.ws + WS_CTL) + CW_BAR, MISC + 8); }
    REPEAT(REP_P0, ph_p0(A)); grid_bar(A);
    layer_body<0>(A);
    layer_body<1>(A);
}
static void launch_all(const Args& a, int grid, hipStream_t stream) {
    static bool attr = false; if (!attr) { (void)hipFuncSetAttribute((const void*)fwd_kernel, hipFuncAttributeMaxDynamicSharedMemorySize, LDS_BYTES); attr = true; }
    hipLaunchKernelGGL(fwd_kernel, dim3(grid), dim3(NTHR), LDS_BYTES, stream, a);
}
#endif

extern "C" void kernel_launch(void* const* d_in, const int* in_sizes, int n_in, void* d_out, int out_size, void* d_ws, size_t ws_size, hipStream_t stream) {
    static int grid = 0;
    if (grid == 0) {
        if (n_in != 28 || out_size != NTOK * DM || ws_size < WS_END) { fprintf(stderr, "kernel_launch: unexpected problem: n_in %d out %d ws %zu (need %zu)\n", n_in, out_size, ws_size, (size_t)WS_END); grid = -1; return; }
        int dev = 0, cus = 0;
        if (hipGetDevice(&dev) != hipSuccess || hipDeviceGetAttribute(&cus, hipDeviceAttributeMultiprocessorCount, dev) != hipSuccess) { grid = -1; return; }
        grid = cus;
    }
    if (grid < 0) return;
    (void)hipMemsetAsync((char*)d_ws + WS_CTL, 0, CTL_BYTES, stream);
    Args a{};
    for (int i = 0; i < 28; ++i) a.in[i] = (const float*)d_in[i];
    a.out = (float*)d_out; a.ws = (unsigned char*)d_ws;
    launch_all(a, grid, stream);
}
```

```cpp
#include <hip/hip_runtime.h>
#include <cstdio>
#include <cstdint>
#define MULTI_LAUNCH 0
#define NAIVE_DN 0
#define NAIVE_SWA 0
#define NAIVE_S5 0
namespace pg8 {
#define PG8_LAS __attribute__((address_space(3)))
typedef unsigned short bf16_t;
typedef short bf16x8 __attribute__((ext_vector_type(8)));
typedef float f32x4 __attribute__((ext_vector_type(4)));
typedef unsigned u32x4 __attribute__((ext_vector_type(4)));
constexpr int BM = 256, BK = 64, HALF = 128, HTB = HALF * BK * 2  , STAGE_BYTES = 8 * HTB, NXCD = 8, WGM = 4;

__host__ __device__ __forceinline__ int lds_byte(int r, int c) { const int st = (r >> 4) * 2 + (c >> 5), rr = r & 15, cc = c & 31, ob = rr * 64 + cc * 2; return st * 1024 + (ob ^ (((ob >> 9) & 1) << 5)); }
__host__ __device__ __forceinline__ void stage_rc(int b, int& R, int& C) { const int st = b / 1024, sb = b % 1024, swz = sb ^ (((sb >> 9) & 1) << 5); R = (st >> 1) * 16 + swz / 64; C = (st & 1) * 32 + (swz % 64) / 2; }
__host__ __device__ __forceinline__ int perm32(int rho) { const int n = rho >> 4, i = rho & 15; return 8 * (i >> 2) + 4 * n + (i & 3); }

struct Unit { int pm, pn, pb, ks; };
struct Gemm { const bf16_t* A; const bf16_t* Bt; int M, N, K; };

struct StaticOrder {
    static constexpr bool SPLITK = false; static constexpr int NSPLIT = 1;
    int nM, nN, nwg, G, c;
    __host__ __device__ void init(int M, int N, int G_, int c_) { nM = M / BM; nN = N / BM; nwg = nM * nN; G = G_; c = c_; }
    __host__ __device__ bool next(int i, Unit& u) const {
        const long L = (long)i * G + c; if (L >= nwg) return false;
        int wgid = (int)L; { const int q = nwg / NXCD, r = nwg % NXCD, xcd = wgid % NXCD, off = wgid / NXCD; wgid = (xcd < r ? xcd * (q + 1) : r * (q + 1) + (xcd - r) * q) + off; }
        const int nig = WGM * nN, gid = wgid / nig, fm = gid * WGM, gsz = (nM - fm) < WGM ? (nM - fm) : WGM;
        u.pm = fm + ((wgid % nig) % gsz); u.pn = (wgid % nig) / gsz; u.pb = u.pn; return true;
    }
    __device__ __forceinline__ void a_ready(const Unit&) const {}
    __device__ __forceinline__ void done(const Unit&) const {}
};

__device__ __forceinline__ unsigned cvt_pk_bf16(float lo, float hi) { unsigned r; asm volatile("v_cvt_pk_bf16_f32 %0, %1, %2" : "=v"(r) : "v"(lo), "v"(hi)); return r; }
typedef float f32x2 __attribute__((ext_vector_type(2)));
template <class Epi, class Sched, bool ALIGN_EPI = false, bool SP2 = false, bool FP8 = false, bool I8 = false>
__device__ __forceinline__ void gemm_phase(PG8_LAS unsigned char* lds, const Gemm g, const Sched& S, const Epi& E) {
    int tid_ = threadIdx.x; asm volatile("" : "+v"(tid_));
    const int tid = tid_, wid = __builtin_amdgcn_readfirstlane(tid >> 6), lane = tid & 63, wr = wid >> 2, wc = wid & 3, fr = lane & 15, fq = lane >> 4;
    const int K = g.K, nt = K / BK;
    unsigned voffA[2], voffB[2];
#pragma unroll
    for (int i = 0; i < 2; ++i) { int R, C; stage_rc(tid * 16 + i * 8192, R, C); const int Rb = Epi::PERM ? ((R & ~31) + perm32(R & 31)) : R;
        voffA[i] = (unsigned)(R * K + C) * 2u; voffB[i] = (unsigned)(Rb * K + C) * 2u; }
    const size_t kstep = (size_t)(BK * 2);
    const size_t hstep = (size_t)HALF * K * 2;
    const size_t tstep = 2 * hstep;
    const unsigned ldsw = (unsigned)wid * 1024u;
    const int aoff = lds_byte(wr * 64 + fr, fq * 8), boff = lds_byte(wc * 32 + fr, fq * 8);
    const size_t sdelta = (size_t)64 * K * 2;
    PG8_LAS unsigned char* ldsB = lds + 4 * HTB + boff; asm volatile("" : "+v"(ldsB));
#define PG8_SA(b, h) (((b) * 2 + (h)) * HTB)
#define PG8_SB(b, h) ((4 + (b) * 2 + (h)) * HTB)
#define PG8_STAGE(bufoff, gbase, voff) do { _Pragma("unroll") for (int _i = 0; _i < 2; ++_i) \
        __builtin_amdgcn_global_load_lds((const unsigned*)((const char*)(gbase) + (size_t)_i * sdelta + (voff)[0]), (PG8_LAS unsigned*)(lds + (bufoff) + ldsw + _i * 8192), 16, 0, 0); } while (0)
#define PG8_LDA(dst, b, h) do { _Pragma("unroll") for (int m = 0; m < 4; ++m) _Pragma("unroll") for (int k = 0; k < 2; ++k) dst[m][k] = *(const PG8_LAS bf16x8*)(lds + PG8_SA(b, h) + aoff + m * 2048 + k * 1024); } while (0)
#define PG8_LDB(dst, b, h) do { _Pragma("unroll") for (int n = 0; n < 2; ++n) _Pragma("unroll") for (int k = 0; k < 2; ++k) dst[n][k] = *(const PG8_LAS bf16x8*)(ldsB + ((b) * 2 + (h)) * HTB + n * 2048 + k * 1024); } while (0)
#define PG8_MMA(ai, bj, At, Bt) do { __builtin_amdgcn_s_setprio(1); _Pragma("unroll") for (int m = 0; m < 4; ++m) _Pragma("unroll") for (int n = 0; n < 2; ++n) { \
        if constexpr (FP8) { typedef int i32x8_ __attribute__((ext_vector_type(8))); typedef int i32x4_ __attribute__((ext_vector_type(4))); \
            const i32x4_ a0_ = __builtin_bit_cast(i32x4_, At[m][0]), a1_ = __builtin_bit_cast(i32x4_, At[m][1]), b0_ = __builtin_bit_cast(i32x4_, Bt[n][0]), b1_ = __builtin_bit_cast(i32x4_, Bt[n][1]); \
            const i32x8_ a8_ = __builtin_shufflevector(a0_, a1_, 0, 1, 2, 3, 4, 5, 6, 7), b8_ = __builtin_shufflevector(b0_, b1_, 0, 1, 2, 3, 4, 5, 6, 7); \
            asm("v_mfma_f32_16x16x128_f8f6f4 %0, %1, %2, %0" : "+v"(acc[ai][bj][m][n]) : "v"(b8_), "v"(a8_)); }   \
        else if constexpr (I8) { typedef int i32x4_ __attribute__((ext_vector_type(4))); \
            _Pragma("unroll") for (int k = 0; k < 2; ++k) acc[ai][bj][m][n] = __builtin_bit_cast(f32x4, __builtin_amdgcn_mfma_i32_16x16x64_i8(__builtin_bit_cast(i32x4_, Bt[n][k]), __builtin_bit_cast(i32x4_, At[m][k]), __builtin_bit_cast(i32x4_, acc[ai][bj][m][n]), 0, 0, 0)); } \
        else { _Pragma("unroll") for (int k = 0; k < 2; ++k) acc[ai][bj][m][n] = __builtin_amdgcn_mfma_f32_16x16x32_bf16(Bt[n][k], At[m][k], acc[ai][bj][m][n], 0, 0, 0); } } \
        __builtin_amdgcn_s_setprio(0); } while (0)
#define PG8_WAIT_V(n) asm volatile("s_waitcnt vmcnt(" #n ")" ::: "memory")
#define PG8_WAIT_L(n) asm volatile("s_waitcnt lgkmcnt(" #n ")" ::: "memory")
#define PG8_BAR __builtin_amdgcn_s_barrier()
#define PG8_SCHED __builtin_amdgcn_sched_barrier(0)
    Unit cur, nxt; int ui = 0;
    if (!S.next(0, cur)) return;
    f32x4 acc[2][2][4][2];
#pragma unroll
    for (int a = 0; a < 2; ++a)
#pragma unroll
        for (int b = 0; b < 2; ++b)
#pragma unroll
            for (int m = 0; m < 4; ++m)
#pragma unroll
                for (int n = 0; n < 2; ++n) acc[a][b][m][n] = (f32x4){0.f, 0.f, 0.f, 0.f};
    bf16x8 At[4][2], B0[2][2], B1[2][2];
    const char* cA = (const char*)g.A + (size_t)cur.pm * tstep; const char* cB = (const char*)g.Bt + (size_t)cur.pb * tstep;
    int ntu = nt;
    if constexpr (Sched::SPLITK) { if (cur.ks >= 0) { ntu = nt / Sched::NSPLIT; const size_t ko = (size_t)cur.ks * (size_t)ntu * kstep; cA += ko; cB += ko; } }
    S.a_ready(cur);
    if constexpr (SP2) {
        PG8_STAGE(PG8_SB(0, 0), cB, voffB); PG8_STAGE(PG8_SB(0, 1), cB + hstep, voffB); PG8_STAGE(PG8_SA(0, 0), cA, voffA); PG8_STAGE(PG8_SA(0, 1), cA + hstep, voffA);
        if (wr == 1) PG8_BAR;
        PG8_WAIT_V(2); PG8_BAR;
        PG8_STAGE(PG8_SB(1, 0), cB + kstep, voffB); PG8_STAGE(PG8_SA(1, 0), cA + kstep, voffA); PG8_STAGE(PG8_SB(1, 1), cB + hstep + kstep, voffB);
        PG8_WAIT_V(6); PG8_BAR;
    } else {
        PG8_STAGE(PG8_SB(0, 0), cB, voffB); PG8_STAGE(PG8_SA(0, 0), cA, voffA); PG8_STAGE(PG8_SB(0, 1), cB + hstep, voffB); PG8_STAGE(PG8_SA(0, 1), cA + hstep, voffA);
        if (wr == 1) PG8_BAR;
        PG8_WAIT_V(4); PG8_BAR;
        PG8_STAGE(PG8_SB(1, 0), cB + kstep, voffB); PG8_STAGE(PG8_SA(1, 0), cA + kstep, voffA); PG8_STAGE(PG8_SB(1, 1), cB + hstep + kstep, voffB);
        PG8_WAIT_V(6); PG8_BAR;
    }
    for (;;) {
        const bool has_next = S.next(ui + 1, nxt);
        const char* nA = has_next ? (const char*)g.A + (size_t)nxt.pm * tstep : cA; const char* nB = has_next ? (const char*)g.Bt + (size_t)nxt.pb * tstep : cB;
        if constexpr (Sched::SPLITK) { if (has_next && nxt.ks >= 0) { const size_t ko = (size_t)nxt.ks * (size_t)(nt / Sched::NSPLIT) * kstep; nA += ko; nB += ko; } }
        for (int t = 0; t < ntu; t += 2) {
            const bool last = (t == ntu - 2);
            const char* a1 = cA + (size_t)(t + 1) * kstep;
            const char* a2 = last ? nA : cA + (size_t)(t + 2) * kstep; const char* b2 = last ? nB : cB + (size_t)(t + 2) * kstep;
            const char* a3 = a2 + kstep; const char* b3 = b2 + kstep;
            if (last && has_next) S.a_ready(nxt);
            if constexpr (SP2) {
            PG8_LDB(B0, 0, 0); PG8_LDB(B1, 0, 1); PG8_SCHED; PG8_LDA(At, 0, 0); PG8_STAGE(PG8_SA(1, 1), a1 + hstep, voffA);
            PG8_WAIT_V(8); PG8_WAIT_L(0); PG8_BAR; PG8_MMA(0, 0, At, B0); PG8_MMA(0, 1, At, B1); PG8_BAR; PG8_SCHED;
            PG8_LDA(At, 0, 1); PG8_STAGE(PG8_SB(0, 0), b2, voffB); PG8_STAGE(PG8_SB(0, 1), b2 + hstep, voffB); PG8_STAGE(PG8_SA(0, 0), a2, voffA);
            PG8_WAIT_V(8); PG8_WAIT_L(0); PG8_BAR; PG8_MMA(1, 0, At, B0); PG8_MMA(1, 1, At, B1); PG8_BAR; PG8_SCHED;
            PG8_LDB(B0, 1, 0); PG8_LDB(B1, 1, 1); PG8_SCHED; PG8_LDA(At, 1, 0); PG8_STAGE(PG8_SA(0, 1), a2 + hstep, voffA);
            PG8_WAIT_V(8); PG8_WAIT_L(0); PG8_BAR; PG8_MMA(0, 0, At, B0); PG8_MMA(0, 1, At, B1); PG8_BAR; PG8_SCHED;
            PG8_LDA(At, 1, 1); PG8_STAGE(PG8_SB(1, 0), b3, voffB); PG8_STAGE(PG8_SB(1, 1), b3 + hstep, voffB); PG8_STAGE(PG8_SA(1, 0), a3, voffA);
            PG8_WAIT_V(8); PG8_WAIT_L(0); PG8_BAR; PG8_MMA(1, 0, At, B0); PG8_MMA(1, 1, At, B1); PG8_BAR; PG8_SCHED;
            } else {
            PG8_LDB(B0, 0, 0); PG8_SCHED; PG8_LDA(At, 0, 0); PG8_STAGE(PG8_SA(1, 1), a1 + hstep, voffA);
            PG8_WAIT_L(8); PG8_BAR; PG8_WAIT_L(0); PG8_MMA(0, 0, At, B0); PG8_BAR; PG8_SCHED;
            PG8_LDB(B1, 0, 1); PG8_STAGE(PG8_SB(0, 0), b2, voffB);
            PG8_BAR; PG8_WAIT_L(0); PG8_MMA(0, 1, At, B1); PG8_BAR;
            PG8_LDA(At, 0, 1); PG8_STAGE(PG8_SA(0, 0), a2, voffA);
            PG8_BAR; PG8_WAIT_L(0); PG8_MMA(1, 0, At, B0); PG8_BAR; PG8_SCHED;
            PG8_STAGE(PG8_SB(0, 1), b2 + hstep, voffB);
            PG8_WAIT_V(6); PG8_BAR; PG8_MMA(1, 1, At, B1); PG8_BAR;
            PG8_LDB(B0, 1, 0); PG8_SCHED; PG8_LDA(At, 1, 0); PG8_STAGE(PG8_SA(0, 1), a2 + hstep, voffA);
            PG8_WAIT_L(8); PG8_BAR; PG8_WAIT_L(0); PG8_MMA(0, 0, At, B0); PG8_BAR; PG8_SCHED;
            PG8_LDB(B1, 1, 1); PG8_STAGE(PG8_SB(1, 0), b3, voffB);
            PG8_BAR; PG8_WAIT_L(0); PG8_MMA(0, 1, At, B1); PG8_BAR;
            PG8_LDA(At, 1, 1); PG8_STAGE(PG8_SA(1, 0), a3, voffA);
            PG8_BAR; PG8_WAIT_L(0); PG8_MMA(1, 0, At, B0); PG8_BAR; PG8_SCHED;
            PG8_STAGE(PG8_SB(1, 1), b3 + hstep, voffB);
            PG8_WAIT_V(6); PG8_BAR; PG8_MMA(1, 1, At, B1); PG8_BAR;
            }
        }
        if constexpr (ALIGN_EPI) { if (wr == 0) PG8_BAR; }
        if constexpr (FP8) asm volatile("s_nop 15\n\ts_nop 15" ::: "memory");
        if constexpr (!Epi::AFTER_DRAIN) { E(acc, cur, wr, wc, fr, fq); S.done(cur); }
        if (!has_next) break;
#pragma unroll
        for (int a = 0; a < 2; ++a)
#pragma unroll
            for (int b = 0; b < 2; ++b)
#pragma unroll
                for (int m = 0; m < 4; ++m)
#pragma unroll
                    for (int n = 0; n < 2; ++n) acc[a][b][m][n] = (f32x4){0.f, 0.f, 0.f, 0.f};
        cur = nxt; cA = nA; cB = nB; ++ui;
        if constexpr (Sched::SPLITK) ntu = cur.ks >= 0 ? nt / Sched::NSPLIT : nt;
        if constexpr (ALIGN_EPI) { if (wr == 1) PG8_BAR; }
    }
    PG8_WAIT_V(0);
    if constexpr (!ALIGN_EPI) { if (wr == 0) PG8_BAR; }
    PG8_BAR;
    if constexpr (Epi::AFTER_DRAIN) { E.fused(acc, cur, wr, wc, fr, fq, lds, wid, lane); S.done(cur); }
#undef PG8_SA
#undef PG8_SB
#undef PG8_STAGE
#undef PG8_LDA
#undef PG8_LDB
#undef PG8_MMA
#undef PG8_WAIT_V
#undef PG8_WAIT_L
#undef PG8_BAR
#undef PG8_SCHED
}
}
namespace pg8 {
__device__ __forceinline__ float fast_sigmoid(float x) { return __builtin_amdgcn_rcpf(1.0f + __expf(-x)); }
struct EpiStore {
    static constexpr bool PERM = true, AFTER_DRAIN = false;
    bf16_t* O; int ldc;
    __device__ __forceinline__ void operator()(const f32x4 (&acc)[2][2][4][2], const Unit& u, int wr, int wc, int fr, int fq) const {
        const int row0 = u.pm * BM + wr * 64 + fr, col0 = u.pn * BM + wc * 32 + 8 * fq;
#pragma unroll
        for (int ai = 0; ai < 2; ++ai)
#pragma unroll
            for (int m = 0; m < 4; ++m) { bf16_t* rowp = O + (size_t)(row0 + ai * HALF + m * 16) * ldc + col0;
#pragma unroll
                for (int bj = 0; bj < 2; ++bj) { const f32x4 v0 = acc[ai][bj][m][0], v1 = acc[ai][bj][m][1];
                    u32x4 w; w.x = cvt_pk_bf16(v0[0], v0[1]); w.y = cvt_pk_bf16(v0[2], v0[3]); w.z = cvt_pk_bf16(v1[0], v1[1]); w.w = cvt_pk_bf16(v1[2], v1[3]);
                    *(u32x4*)(rowp + bj * HALF) = w; } }
    }
};
struct EpiSwiGLU {
    static constexpr bool PERM = true, AFTER_DRAIN = false;
    bf16_t* O; int ldc;
    __device__ __forceinline__ void operator()(const f32x4 (&acc)[2][2][4][2], const Unit& u, int wr, int wc, int fr, int fq) const {
        const int row0 = u.pm * BM + wr * 64 + fr, col0 = u.pn * HALF + wc * 32 + 8 * fq;
#pragma unroll
        for (int ai = 0; ai < 2; ++ai)
#pragma unroll
            for (int m = 0; m < 4; ++m) { bf16_t* rowp = O + (size_t)(row0 + ai * HALF + m * 16) * ldc + col0;
                f32x4 h0, h1;
#pragma unroll
                for (int j = 0; j < 4; ++j) { const float g0 = acc[ai][0][m][0][j], g1 = acc[ai][0][m][1][j];
                    h0[j] = g0 * fast_sigmoid(g0) * acc[ai][1][m][0][j]; h1[j] = g1 * fast_sigmoid(g1) * acc[ai][1][m][1][j]; }
                u32x4 w; w.x = cvt_pk_bf16(h0[0], h0[1]); w.y = cvt_pk_bf16(h0[2], h0[3]); w.z = cvt_pk_bf16(h1[0], h1[1]); w.w = cvt_pk_bf16(h1[2], h1[3]);
                *(u32x4*)rowp = w; }
    }
};
struct EpiGLU {
    static constexpr bool PERM = true, AFTER_DRAIN = false;
    bf16_t* O; const bf16_t* Z; const float* bias; int ldc;
    __device__ __forceinline__ void operator()(const f32x4 (&acc)[2][2][4][2], const Unit& u, int wr, int wc, int fr, int fq) const {
        const int row0 = u.pm * BM + wr * 64 + fr, col0 = u.pn * BM + wc * 32 + 8 * fq;
#pragma unroll
        for (int ai = 0; ai < 2; ++ai)
#pragma unroll
            for (int m = 0; m < 4; ++m) { const size_t off = (size_t)(row0 + ai * HALF + m * 16) * ldc + col0;
#pragma unroll
                for (int bj = 0; bj < 2; ++bj) { const u32x4 zz = *(const u32x4*)(Z + off + bj * HALF);
                    const f32x4 b0 = *(const f32x4*)(bias + col0 + bj * HALF), b1 = *(const f32x4*)(bias + col0 + bj * HALF + 4);
                    const f32x4 v0 = acc[ai][bj][m][0] + b0, v1 = acc[ai][bj][m][1] + b1;
                    float z[8]; z[0] = __uint_as_float(zz.x << 16); z[1] = __uint_as_float(zz.x & 0xffff0000u); z[2] = __uint_as_float(zz.y << 16); z[3] = __uint_as_float(zz.y & 0xffff0000u);
                    z[4] = __uint_as_float(zz.z << 16); z[5] = __uint_as_float(zz.z & 0xffff0000u); z[6] = __uint_as_float(zz.w << 16); z[7] = __uint_as_float(zz.w & 0xffff0000u);
                    u32x4 w; w.x = cvt_pk_bf16(z[0] * fast_sigmoid(v0[0]), z[1] * fast_sigmoid(v0[1])); w.y = cvt_pk_bf16(z[2] * fast_sigmoid(v0[2]), z[3] * fast_sigmoid(v0[3]));
                    w.z = cvt_pk_bf16(z[4] * fast_sigmoid(v1[0]), z[5] * fast_sigmoid(v1[1])); w.w = cvt_pk_bf16(z[6] * fast_sigmoid(v1[2]), z[7] * fast_sigmoid(v1[3]));
                    *(u32x4*)(O + off + bj * HALF) = w; } }
    }
};
typedef unsigned u32x2 __attribute__((ext_vector_type(2)));
__device__ __forceinline__ unsigned cvt4_fp8(float a, float b, float c, float d) {
    a = __builtin_fminf(__builtin_fmaxf(a, -448.f), 448.f); b = __builtin_fminf(__builtin_fmaxf(b, -448.f), 448.f); c = __builtin_fminf(__builtin_fmaxf(c, -448.f), 448.f); d = __builtin_fminf(__builtin_fmaxf(d, -448.f), 448.f);
    unsigned w = 0u; w = __builtin_amdgcn_cvt_pk_fp8_f32(a, b, w, false); w = __builtin_amdgcn_cvt_pk_fp8_f32(c, d, w, true); return w; }
struct EpiStoreScaled {
    static constexpr bool PERM = true, AFTER_DRAIN = false;
    bf16_t* O; int ldc; float scale;
    __device__ __forceinline__ void operator()(const f32x4 (&acc)[2][2][4][2], const Unit& u, int wr, int wc, int fr, int fq) const {
        const int row0 = u.pm * BM + wr * 64 + fr, col0 = u.pn * BM + wc * 32 + 8 * fq;
#pragma unroll
        for (int ai = 0; ai < 2; ++ai)
#pragma unroll
            for (int m = 0; m < 4; ++m) { bf16_t* rowp = O + (size_t)(row0 + ai * HALF + m * 16) * ldc + col0;
#pragma unroll
                for (int bj = 0; bj < 2; ++bj) { const f32x4 v0 = acc[ai][bj][m][0] * scale, v1 = acc[ai][bj][m][1] * scale;
                    u32x4 w; w.x = cvt_pk_bf16(v0[0], v0[1]); w.y = cvt_pk_bf16(v0[2], v0[3]); w.z = cvt_pk_bf16(v1[0], v1[1]); w.w = cvt_pk_bf16(v1[2], v1[3]);
                    *(u32x4*)(rowp + bj * HALF) = w; } }
    }
};
struct EpiSwiGLU8 {
    static constexpr bool PERM = true, AFTER_DRAIN = false;
    unsigned char* O; int ldc; float s_in, s_out;
    __device__ __forceinline__ void operator()(const f32x4 (&acc)[2][2][4][2], const Unit& u, int wr, int wc, int fr, int fq) const {
        const int row0 = u.pm * BM + wr * 64 + fr, col0 = u.pn * HALF + wc * 32 + 8 * fq; const float kE = -s_in * 1.4426950408889634f, iC = 1.0f / (s_in * s_in * s_out);
#pragma unroll
        for (int ai = 0; ai < 2; ++ai)
#pragma unroll
            for (int m = 0; m < 4; ++m) { unsigned char* rowp = O + (size_t)(row0 + ai * HALF + m * 16) * ldc + col0;
                float h[8];
#pragma unroll
                for (int n = 0; n < 2; ++n) { const f32x4 g = acc[ai][0][m][n], uu = acc[ai][1][m][n]; const f32x4 t = g * kE; f32x4 ex, r;
#pragma unroll
                    for (int j = 0; j < 4; ++j) ex[j] = __builtin_amdgcn_exp2f(t[j]);
                    const f32x4 d = ex * iC + iC;
#pragma unroll
                    for (int j = 0; j < 4; ++j) r[j] = __builtin_amdgcn_rcpf(d[j]);
                    const f32x4 hv = (g * uu) * r; h[4 * n] = hv[0]; h[4 * n + 1] = hv[1]; h[4 * n + 2] = hv[2]; h[4 * n + 3] = hv[3]; }
                u32x2 w; w.x = cvt4_fp8(h[0], h[1], h[2], h[3]); w.y = cvt4_fp8(h[4], h[5], h[6], h[7]);
                *(u32x2*)rowp = w; }
    }
};
struct EpiSwiGLUi8 {
    static constexpr bool PERM = true, AFTER_DRAIN = false;
    bf16_t* O; int ldc; const float* rowscale; const unsigned* colmax;
    __device__ __forceinline__ void operator()(const f32x4 (&acc)[2][2][4][2], const Unit& u, int wr, int wc, int fr, int fq) const {
        typedef int i32x4_ __attribute__((ext_vector_type(4)));
        const int row0 = u.pm * BM + wr * 64 + fr, col0 = u.pn * HALF + wc * 32 + 8 * fq, n0 = u.pn * BM + wc * 32 + 8 * fq;
        const f32x4 cg0 = *(const f32x4*)(colmax + n0) * (1.0f / 127.0f), cg1 = *(const f32x4*)(colmax + n0 + 4) * (1.0f / 127.0f), cu0 = *(const f32x4*)(colmax + n0 + HALF) * (1.0f / 127.0f), cu1 = *(const f32x4*)(colmax + n0 + HALF + 4) * (1.0f / 127.0f);
        const f32x4 ke0 = cg0 * -1.4426950408889634f, ke1 = cg1 * -1.4426950408889634f, cc0 = cg0 * cu0, cc1 = cg1 * cu1;
#pragma unroll
        for (int ai = 0; ai < 2; ++ai)
#pragma unroll
            for (int m = 0; m < 4; ++m) { const int row = row0 + ai * HALF + m * 16; bf16_t* rowp = O + (size_t)row * ldc + col0; const float rs = rowscale[row];
                const i32x4_ g0i = __builtin_bit_cast(i32x4_, acc[ai][0][m][0]), g1i = __builtin_bit_cast(i32x4_, acc[ai][0][m][1]), u0i = __builtin_bit_cast(i32x4_, acc[ai][1][m][0]), u1i = __builtin_bit_cast(i32x4_, acc[ai][1][m][1]);
                f32x4 h0, h1;
                { const f32x4 gs = __builtin_convertvector(g0i, f32x4) * rs, us = __builtin_convertvector(u0i, f32x4) * rs; const f32x4 t = gs * ke0; f32x4 ex, r;
#pragma unroll
                  for (int j = 0; j < 4; ++j) ex[j] = __builtin_amdgcn_exp2f(t[j]);
                  const f32x4 d = ex + 1.0f;
#pragma unroll
                  for (int j = 0; j < 4; ++j) r[j] = __builtin_amdgcn_rcpf(d[j]);
                  h0 = ((gs * us) * cc0) * r; }
                { const f32x4 gs = __builtin_convertvector(g1i, f32x4) * rs, us = __builtin_convertvector(u1i, f32x4) * rs; const f32x4 t = gs * ke1; f32x4 ex, r;
#pragma unroll
                  for (int j = 0; j < 4; ++j) ex[j] = __builtin_amdgcn_exp2f(t[j]);
                  const f32x4 d = ex + 1.0f;
#pragma unroll
                  for (int j = 0; j < 4; ++j) r[j] = __builtin_amdgcn_rcpf(d[j]);
                  h1 = ((gs * us) * cc1) * r; }
                u32x4 w; w.x = cvt_pk_bf16(h0[0], h0[1]); w.y = cvt_pk_bf16(h0[2], h0[3]); w.z = cvt_pk_bf16(h1[0], h1[1]); w.w = cvt_pk_bf16(h1[2], h1[3]);
                *(u32x4*)rowp = w; }
    }
};
struct EpiStoreI8 {
    static constexpr bool PERM = true, AFTER_DRAIN = false;
    bf16_t* O; int ldc; const float* rowscale; const unsigned* colmax;
    __device__ __forceinline__ void operator()(const f32x4 (&acc)[2][2][4][2], const Unit& u, int wr, int wc, int fr, int fq) const {
        typedef int i32x4_ __attribute__((ext_vector_type(4)));
        const int row0 = u.pm * BM + wr * 64 + fr, col0 = u.pn * BM + wc * 32 + 8 * fq;
        f32x4 cs[2][2];
#pragma unroll
        for (int bj = 0; bj < 2; ++bj) { cs[bj][0] = *(const f32x4*)(colmax + col0 + bj * HALF) * (1.0f / 127.0f); cs[bj][1] = *(const f32x4*)(colmax + col0 + bj * HALF + 4) * (1.0f / 127.0f); }
#pragma unroll
        for (int ai = 0; ai < 2; ++ai)
#pragma unroll
            for (int m = 0; m < 4; ++m) { const int row = row0 + ai * HALF + m * 16; bf16_t* rowp = O + (size_t)row * ldc + col0; const float rs = rowscale[row];
#pragma unroll
                for (int bj = 0; bj < 2; ++bj) { const i32x4_ v0 = __builtin_bit_cast(i32x4_, acc[ai][bj][m][0]), v1 = __builtin_bit_cast(i32x4_, acc[ai][bj][m][1]);
                    const f32x4 f0 = (__builtin_convertvector(v0, f32x4) * rs) * cs[bj][0], f1 = (__builtin_convertvector(v1, f32x4) * rs) * cs[bj][1];
                    u32x4 w; w.x = cvt_pk_bf16(f0[0], f0[1]); w.y = cvt_pk_bf16(f0[2], f0[3]); w.z = cvt_pk_bf16(f1[0], f1[1]); w.w = cvt_pk_bf16(f1[2], f1[3]);
                    *(u32x4*)(rowp + bj * HALF) = w; } }
    }
};
struct ExpertOrder {
    static constexpr bool SPLITK = false; static constexpr int NSPLIT = 1;
    int nM, nN, nwg, G, c; const int* tile_e;
    __device__ void init(int nM_, int nN_, int G_, int c_, const int* te) { nM = nM_; nN = nN_; nwg = nM * nN; G = G_; c = c_; tile_e = te; }
    __device__ bool next(int i, Unit& u) const {
        const long L = (long)i * G + c; if (L >= nwg) return false;
        int wgid = (int)L; { const int q = nwg / NXCD, r = nwg % NXCD, xcd = wgid % NXCD, off = wgid / NXCD; wgid = (xcd < r ? xcd * (q + 1) : r * (q + 1) + (xcd - r) * q) + off; }
        const int nig = WGM * nN, gid = wgid / nig, fm = gid * WGM, gsz = (nM - fm) < WGM ? (nM - fm) : WGM;
        u.pm = fm + ((wgid % nig) % gsz); u.pn = (wgid % nig) / gsz; u.pb = (tile_e ? tile_e[u.pm] : 0) * nN + u.pn; return true;
    }
    __device__ __forceinline__ void a_ready(const Unit&) const {}
    __device__ __forceinline__ void done(const Unit&) const {}
};
struct ExpertOrderSplit {
    static constexpr bool SPLITK = true; static constexpr int NSPLIT = 4;
    int nM, nN, NF, nfull, nwg, G, c; const int* tile_e;
    __device__ void init(int nM_, int nN_, int NF_, int G_, int c_, const int* te) { nM = nM_; nN = nN_; NF = nM_ < NF_ ? nM_ : NF_; nfull = NF * nN; nwg = nfull + (nM - NF) * nN * NSPLIT; G = G_; c = c_; tile_e = te; }
    __device__ bool next(int i, Unit& u) const {
        const long L = (long)i * G + c; if (L >= nwg) return false;
        if (L < nfull) { int wgid = (int)L; { const int q = nfull / NXCD, r = nfull % NXCD, xcd = wgid % NXCD, off = wgid / NXCD; wgid = (xcd < r ? xcd * (q + 1) : r * (q + 1) + (xcd - r) * q) + off; }
            const int nig = WGM * nN, gid = wgid / nig, fm = gid * WGM, gsz = (NF - fm) < WGM ? (NF - fm) : WGM;
            u.pm = fm + ((wgid % nig) % gsz); u.pn = (wgid % nig) / gsz; u.ks = -1; }
        else { const int idx = (int)L - nfull; u.ks = idx % NSPLIT; u.pn = (idx / NSPLIT) % nN; u.pm = NF + idx / (NSPLIT * nN); }
        u.pb = tile_e[u.pm] * nN + u.pn; return true;
    }
    __device__ __forceinline__ void a_ready(const Unit&) const {}
    __device__ __forceinline__ void done(const Unit&) const {}
};
struct EpiStoreScaledSplit {
    static constexpr bool PERM = true, AFTER_DRAIN = false;
    bf16_t* O; float* P; int ldc; float scale; int NF; size_t pslice;
    __device__ __forceinline__ void operator()(const f32x4 (&acc)[2][2][4][2], const Unit& u, int wr, int wc, int fr, int fq) const {
        const int col0 = u.pn * BM + wc * 32 + 8 * fq;
        if (u.ks < 0) { const int row0 = u.pm * BM + wr * 64 + fr;
#pragma unroll
            for (int ai = 0; ai < 2; ++ai)
#pragma unroll
                for (int m = 0; m < 4; ++m) { bf16_t* rowp = O + (size_t)(row0 + ai * HALF + m * 16) * ldc + col0;
#pragma unroll
                    for (int bj = 0; bj < 2; ++bj) { const f32x4 v0 = acc[ai][bj][m][0] * scale, v1 = acc[ai][bj][m][1] * scale;
                        u32x4 w; w.x = cvt_pk_bf16(v0[0], v0[1]); w.y = cvt_pk_bf16(v0[2], v0[3]); w.z = cvt_pk_bf16(v1[0], v1[1]); w.w = cvt_pk_bf16(v1[2], v1[3]);
                        *(u32x4*)(rowp + bj * HALF) = w; } } }
        else { const int row0 = (u.pm - NF) * BM + wr * 64 + fr; float* base = P + (size_t)u.ks * pslice;
#pragma unroll
            for (int ai = 0; ai < 2; ++ai)
#pragma unroll
                for (int m = 0; m < 4; ++m) { float* rowp = base + (size_t)(row0 + ai * HALF + m * 16) * ldc + col0;
#pragma unroll
                    for (int bj = 0; bj < 2; ++bj) { *(f32x4*)(rowp + bj * HALF) = acc[ai][bj][m][0] * scale; *(f32x4*)(rowp + bj * HALF + 4) = acc[ai][bj][m][1] * scale; } } }
    }
};
}
constexpr int NTOK = 16384, DM = 2048, SEQ = 4096, NBATCH = 4, NCHUNK = 64, CHUNK = 64;
constexpr int DIN = 5392, DINP = 5632;
constexpr int C_Q = 0, C_K = 1024, C_V = 2048, C_GATE = 3072, C_BQ = 4096, C_BK = 4608, C_BV = 4736, C_CU = 4864, C_AL = 5376, C_BE = 5384;
constexpr int DFF = 7168, NEXP = 8;
constexpr float EPS = 1e-6f;
#ifndef USE_FP8
#define USE_FP8 1
#endif
#ifndef FP8_E0
#define FP8_E0 1
#endif
#ifndef USE_I8
#define USE_I8 1
#endif
#ifndef USE_I8_WIN
#define USE_I8_WIN 1
#endif
constexpr float F8_SA = 16.f, F8_SW = 256.f, F8_SH = 8.f;
constexpr int NWAVES = 8, NTHR = 512;
constexpr int LDS_BYTES = 147456;
constexpr int LDS_MISC = 131072 + 8192;

constexpr size_t MiB = 1u << 20;
constexpr size_t WS_CTL = 0, CTL_BYTES = 1 * MiB;
constexpr size_t WS_S5TAB = 1 * MiB;
constexpr size_t WS_MISC = 2 * MiB;
constexpr size_t WS_WIN = 4 * MiB, WIN_BYTES = (size_t)DINP * DM * 2;
constexpr size_t WS_WOUT = 48 * MiB, WOUT_BYTES = (size_t)DM * DM * 2;
constexpr size_t WS_WGLU = 64 * MiB, WGLU_BYTES = 512 * 512 * 2;
constexpr size_t WS_FGU = 65 * MiB, GU_BYTES = (size_t)2 * DFF * DM * 2;
constexpr size_t WS_FD = 121 * MiB, D_BYTES = (size_t)DM * DFF * 2;
constexpr size_t WS_MGU = 149 * MiB;
constexpr size_t WS_MD = 597 * MiB;
constexpr size_t WS_HN = 821 * MiB;
constexpr size_t WS_R = 885 * MiB;
constexpr size_t WS_PROJ = WS_R;
constexpr size_t WS_MIXCAT = WS_R + 176 * MiB;
constexpr size_t WS_MIXOUT = WS_R + 240 * MiB;
constexpr size_t WS_Z = WS_R + 304 * MiB;
constexpr size_t WS_GLU = WS_R + 320 * MiB;
constexpr size_t WS_ATT = WS_R + 336 * MiB;
constexpr size_t WS_DNQKV = WS_R + 352 * MiB;
constexpr size_t WS_DNGB = WS_R + 544 * MiB;
constexpr size_t WS_DNO = WS_R + 545 * MiB;
constexpr size_t WS_XS = WS_R + 609 * MiB;
constexpr size_t WS_HID = WS_R;
constexpr size_t WS_XG = WS_R + 476 * MiB;
constexpr size_t WS_YG = WS_R + 612 * MiB;
constexpr size_t WS_YP = WS_R + 748 * MiB;
constexpr int YP_NF = 2 * NTOK / 256;
constexpr size_t YP_SLICE = (size_t)8 * 256 * DM;
constexpr size_t WS_S5E = WS_R + 865 * MiB;
constexpr size_t WS_END = WS_R + 869 * MiB;
constexpr int CW_BAR = 4096;
constexpr int CW_CNT = 16384;
constexpr int CW_COLMAX = 32768;
constexpr int CW_WMAX = 20480;
constexpr int MI_ROUTE = 0;
constexpr int MI_GATE = 65536;
constexpr int MI_ROWS = 65536 + 32768;
constexpr int MI_TILEE = 65536 + 65536;
constexpr int MI_NTILES = MI_TILEE + 256;
constexpr int MI_ROWSC = 196608;

#define LAS __attribute__((address_space(3)))
typedef unsigned short bf16;
typedef float f32x4 __attribute__((ext_vector_type(4)));
typedef float f32x2v __attribute__((ext_vector_type(2)));
typedef unsigned u32x4 __attribute__((ext_vector_type(4)));
typedef unsigned u32x2 __attribute__((ext_vector_type(2)));
typedef short bf16x8 __attribute__((ext_vector_type(8)));
#define LDS_WAIT() asm volatile("s_waitcnt lgkmcnt(0)" ::: "memory")
__device__ __forceinline__ float bflo(unsigned w) { return __uint_as_float(w << 16); }
__device__ __forceinline__ float bfhi(unsigned w) { return __uint_as_float(w & 0xffff0000u); }
__device__ __forceinline__ float bf2f(bf16 v) { return __uint_as_float(((unsigned)v) << 16); }
typedef __bf16 hwbf16x2 __attribute__((ext_vector_type(2)));
typedef float hwf32x2 __attribute__((ext_vector_type(2)));
__device__ __forceinline__ unsigned pk2(float lo, float hi) { const hwf32x2 v = {lo, hi}; return __builtin_bit_cast(unsigned, __builtin_convertvector(v, hwbf16x2)); }
__device__ __forceinline__ unsigned f2bf(float f) { return pk2(f, f) & 0xffffu; }
__device__ __forceinline__ float wave_sum(float v) {
#pragma unroll
    for (int o = 1; o < 64; o <<= 1) v += __shfl_xor(v, o);
    return v;
}
__device__ __forceinline__ float siluf(float x) { return x * __builtin_amdgcn_rcpf(1.0f + __expf(-x)); }
__device__ __forceinline__ float sigmoidf_(float x) { return __builtin_amdgcn_rcpf(1.0f + __expf(-x)); }
__device__ __forceinline__ float softplusf_(float x) { return x > 20.f ? x : log1pf(__expf(x)); }
__device__ __forceinline__ float gelu_tanh(float y) { const float t = 0.7978845608028654f * (y + 0.044715f * y * y * y); return 0.5f * y * (1.0f + tanhf(t)); }

struct Args { const float* in[28]; float* out; unsigned char* ws; };
struct Frame {
    LAS unsigned char* lds;
    int tid, lane, wave, G, bid;
    int gw, ngw;
    int gt, ngt;
    float* out; unsigned char* ws;
};
#define IN_X 0
#define IN_LNG 1
#define IN_WIN 2
#define IN_CONVW 3
#define IN_ALOG 4
#define IN_DTB 5
#define IN_ANORM 6
#define IN_SINKS 7
#define IN_BNORM 8
#define IN_LAMRE 9
#define IN_LAMIM 10
#define IN_LOGDT 11
#define IN_BRE 12
#define IN_BIM 13
#define IN_CRE 14
#define IN_CIM 15
#define IN_S5D 16
#define IN_WGLU 17
#define IN_BGLU 18
#define IN_CNORM 19
#define IN_WOUT 20
#define IN_FWG 21
#define IN_FWU 22
#define IN_FWD 23
#define IN_WR 24
#define IN_MWG 25
#define IN_MWU 26
#define IN_MWD 27

struct TrJob { const float* src; bf16* dst; int ld, K, nv4; };
__device__ __forceinline__ bool tr_decode(const Args& A, unsigned char* ws, int it, TrJob& J) {
    constexpr int I_WIN = 32 * 88, I_WOUT = 32 * 32, I_GLU = 8 * 8, I_GU = 32 * 224, I_D = 112 * 32;
    constexpr int NITEMS = 2 * I_WIN + 2 * I_WOUT + 2 * I_GLU + 9 * I_GU + 9 * I_D;
    if (it >= NITEMS) return false;
    int r = it;
    if (r < 9 * I_GU) { const int e = r / I_GU; r -= e * I_GU; const int kb = r / 224, nb = r % 224, n0 = 64 * nb, k0 = 64 * kb, tile = n0 >> 8, within = n0 & 255;
        const float* g = e == 0 ? A.in[IN_FWG] : A.in[IN_MWG] + (size_t)(e - 1) * DM * DFF; const float* u = e == 0 ? A.in[IN_FWU] : A.in[IN_MWU] + (size_t)(e - 1) * DM * DFF;
        J.src = (within < 128 ? g : u) + (size_t)k0 * DFF + 128 * tile + (within & 127); J.ld = DFF; J.nv4 = 16; J.K = DM;
        J.dst = (bf16*)(ws + (e == 0 ? WS_FGU : WS_MGU + (size_t)(e - 1) * GU_BYTES)) + (size_t)n0 * DM + k0; return true; }
    r -= 9 * I_GU;
    if (r < 9 * I_D) { const int e = r / I_D; r -= e * I_D; const int kb = r / 32, nb = r % 32, n0 = 64 * nb, k0 = 64 * kb;
        J.src = (e == 0 ? A.in[IN_FWD] : A.in[IN_MWD] + (size_t)(e - 1) * DFF * DM) + (size_t)k0 * DM + n0; J.ld = DM; J.nv4 = 16; J.K = DFF;
        J.dst = (bf16*)(ws + (e == 0 ? WS_FD : WS_MD + (size_t)(e - 1) * D_BYTES)) + (size_t)n0 * DFF + k0; return true; }
    r -= 9 * I_D;
    if (r < 2 * I_WIN) { const int l = r / I_WIN; r -= l * I_WIN; const int kb = r / 88, nb = r % 88, n0 = 64 * nb, k0 = 64 * kb;
        int col, nv; if (n0 < 4096) { col = n0; nv = 16; } else if (n0 < 5376) { col = n0 + 16; nv = 16; } else if (n0 == 5376) { col = 4096; nv = 4; } else { col = 0; nv = 0; }
        J.src = A.in[IN_WIN] + (size_t)l * DM * DIN + (size_t)k0 * DIN + col; J.ld = DIN; J.nv4 = nv; J.K = DM; J.dst = (bf16*)(ws + WS_WIN + l * WIN_BYTES) + (size_t)n0 * DM + k0; return true; }
    r -= 2 * I_WIN;
    if (r < 2 * I_WOUT) { const int l = r / I_WOUT; r -= l * I_WOUT; const int kb = r / 32, nb = r % 32, n0 = 64 * nb, k0 = 64 * kb;
        J.src = A.in[IN_WOUT] + (size_t)l * DM * DM + (size_t)k0 * DM + n0; J.ld = DM; J.nv4 = 16; J.K = DM; J.dst = (bf16*)(ws + WS_WOUT + l * WOUT_BYTES) + (size_t)n0 * DM + k0; return true; }
    r -= 2 * I_WOUT;
    { const int l = r / I_GLU; r -= l * I_GLU; const int kb = r / 8, nb = r % 8, n0 = 64 * nb, k0 = 64 * kb;
        J.src = A.in[IN_WGLU] + (size_t)l * 512 * 512 + (size_t)k0 * 512 + n0; J.ld = 512; J.nv4 = 16; J.K = 512; J.dst = (bf16*)(ws + WS_WGLU + l * WGLU_BYTES) + (size_t)n0 * 512 + k0; return true; }
}
__device__ __forceinline__ void tr_load(const TrJob& J, int lane, f32x4 (&v)[16]) {
    const int q = lane >> 4, c = lane & 15; const float* p = J.src + (size_t)(2 * q) * J.ld + (c < J.nv4 ? 4 * c : 0);
#pragma unroll
    for (int i = 0; i < 8; ++i) { v[2 * i] = *(const f32x4*)(p + (size_t)(8 * i) * J.ld); v[2 * i + 1] = *(const f32x4*)(p + (size_t)(8 * i + 1) * J.ld); }
}
__device__ __forceinline__ void tr_store(const TrJob& J, int lane, const f32x4 (&v)[16], LAS unsigned* scr) {
    const int q = lane >> 4, c = lane & 15; const unsigned keep = c < J.nv4 ? 0xffffffffu : 0u;
#pragma unroll
    for (int i = 0; i < 8; ++i)
#pragma unroll
        for (int j = 0; j < 4; ++j) scr[(4 * c + j) * 33 + q + 4 * i] = pk2(v[2 * i][j], v[2 * i + 1][j]) & keep;
    LDS_WAIT(); asm volatile("" ::: "memory");
    const int ch = lane & 7;
#pragma unroll
    for (int m = 0; m < 8; ++m) { const int n = (lane >> 3) + 8 * m; const LAS unsigned* s = scr + n * 33 + 4 * ch;
        u32x4 o; o.x = s[0]; o.y = s[1]; o.z = s[2]; o.w = s[3]; *(u32x4*)(J.dst + (size_t)n * J.K + 8 * ch) = o; }
    LDS_WAIT(); asm volatile("" ::: "memory");
}
__device__ __forceinline__ void tr8_load(const TrJob& J, int lane, f32x4 (&v)[16]) {
    const int q = lane >> 3, c = lane & 7; const float* p = J.src + (size_t)(4 * q) * J.ld + 4 * c;
#pragma unroll
    for (int i = 0; i < 4; ++i)
#pragma unroll
        for (int kk = 0; kk < 4; ++kk) v[4 * i + kk] = *(const f32x4*)(p + (size_t)(32 * i + kk) * J.ld);
}
__device__ __forceinline__ void tr8_store(const TrJob& J, int lane, const f32x4 (&v)[16], LAS unsigned* scr) {
    const int q = lane >> 3, c = lane & 7;
#pragma unroll
    for (int i = 0; i < 4; ++i)
#pragma unroll
        for (int j = 0; j < 4; ++j) scr[(4 * c + j) * 33 + q + 8 * i] = pg8::cvt4_fp8(v[4 * i][j] * F8_SW, v[4 * i + 1][j] * F8_SW, v[4 * i + 2][j] * F8_SW, v[4 * i + 3][j] * F8_SW);
    LDS_WAIT(); asm volatile("" ::: "memory");
    const int ch = lane & 7;
#pragma unroll
    for (int m = 0; m < 4; ++m) { const int n = (lane >> 3) + 8 * m; const LAS unsigned* s = scr + n * 33 + 4 * ch;
        u32x4 o; o.x = s[0]; o.y = s[1]; o.z = s[2]; o.w = s[3]; *(u32x4*)((unsigned char*)J.dst + (size_t)n * J.K + 16 * ch) = o; }
    LDS_WAIT(); asm volatile("" ::: "memory");
}
__device__ __forceinline__ bool tr8_decode(const Args& A, unsigned char* ws, int it, TrJob& J) {
    constexpr int I_GU = 16 * 448, I_D = 56 * 64, NS = 9 - FP8_E0;
    if (it >= NS * (I_GU + I_D)) return false;
    int r = it;
    if (r < NS * I_GU) { const int e = FP8_E0 + r / I_GU; r %= I_GU; const int kb = r / 448, nb = r % 448, n0 = 32 * nb, k0 = 128 * kb, tile = n0 >> 8, within = n0 & 255;
        const float* g = e == 0 ? A.in[IN_FWG] : A.in[IN_MWG] + (size_t)(e - 1) * DM * DFF; const float* u = e == 0 ? A.in[IN_FWU] : A.in[IN_MWU] + (size_t)(e - 1) * DM * DFF;
        J.src = (within < 128 ? g : u) + (size_t)k0 * DFF + 128 * tile + (within & 127); J.ld = DFF; J.nv4 = 16; J.K = DM;
        J.dst = (bf16*)(ws + (e == 0 ? WS_FGU : WS_MGU + (size_t)(e - 1) * (GU_BYTES / 2)) + (size_t)n0 * DM + k0); return true; }
    r -= NS * I_GU;
    { const int e = FP8_E0 + r / I_D; r %= I_D; const int kb = r / 64, nb = r % 64, n0 = 32 * nb, k0 = 128 * kb;
        J.src = (e == 0 ? A.in[IN_FWD] : A.in[IN_MWD] + (size_t)(e - 1) * DFF * DM) + (size_t)k0 * DM + n0; J.ld = DM; J.nv4 = 16; J.K = DFF;
        J.dst = (bf16*)(ws + (e == 0 ? WS_FD : WS_MD + (size_t)(e - 1) * (D_BYTES / 2)) + (size_t)n0 * DFF + k0); return true; }
}
__device__ __forceinline__ bool tr_decode_c(const Args& A, unsigned char* ws, int j, TrJob& J) {
    constexpr int I_GU = 32 * 224, I_D = 112 * 32;
#if USE_FP8
    constexpr int NBG = USE_I8 ? 0 : FP8_E0, NBD = FP8_E0;
    constexpr int SKIPW = USE_I8_WIN ? 2 * 32 * 88 : 0;
    int it; if (j < NBG * I_GU) it = j; else if (j < NBG * I_GU + NBD * I_D) it = 9 * I_GU + (j - NBG * I_GU); else it = 9 * (I_GU + I_D) + SKIPW + (j - NBG * I_GU - NBD * I_D);
    return tr_decode(A, ws, it, J);
#else
    return tr_decode(A, ws, j, J);
#endif
}
__device__ __forceinline__ void p0_weights(const Args& A, const Frame& F) {
    LAS unsigned* scr = (LAS unsigned*)(F.lds + F.wave * 16384);
    TrJob ja, jb; f32x4 va[16], vb[16];
#if USE_FP8
    { int it = F.gw; bool ha = tr8_decode(A, F.ws, it, ja); if (ha) tr8_load(ja, F.lane, va);
      while (ha) {
        it += F.ngw; const bool hb = tr8_decode(A, F.ws, it, jb); if (hb) tr8_load(jb, F.lane, vb);
        tr8_store(ja, F.lane, va, scr);
        if (!hb) break;
        it += F.ngw; ha = tr8_decode(A, F.ws, it, ja); if (ha) tr8_load(ja, F.lane, va);
        tr8_store(jb, F.lane, vb, scr);
      } }
#endif
    int it = F.gw;
    bool ha = tr_decode_c(A, F.ws, it, ja); if (ha) tr_load(ja, F.lane, va);
    while (ha) {
        it += F.ngw; const bool hb = tr_decode_c(A, F.ws, it, jb); if (hb) tr_load(jb, F.lane, vb);
        tr_store(ja, F.lane, va, scr);
        if (!hb) break;
        it += F.ngw; ha = tr_decode_c(A, F.ws, it, ja); if (ha) tr_load(ja, F.lane, va);
        tr_store(jb, F.lane, vb, scr);
    }
}
__device__ __forceinline__ unsigned cvt4_i8(float a, float b, float c, float d) {
    const int ia = (int)__builtin_rintf(fminf(fmaxf(a, -127.f), 127.f)), ib = (int)__builtin_rintf(fminf(fmaxf(b, -127.f), 127.f)), ic = (int)__builtin_rintf(fminf(fmaxf(c, -127.f), 127.f)), id = (int)__builtin_rintf(fminf(fmaxf(d, -127.f), 127.f));
    return (unsigned)(ia & 0xff) | ((unsigned)(ib & 0xff) << 8) | ((unsigned)(ic & 0xff) << 16) | ((unsigned)id << 24); }
__device__ __forceinline__ void p0_i8_strips(const Args& A, const Frame& F) {
    unsigned* ctl = (unsigned*)(F.ws + WS_CTL);
    LAS unsigned* scr = (LAS unsigned*)(F.lds + F.wave * 8704);
    LAS float* red = (LAS float*)(F.lds + 8 * 8704);
    LAS float* cmax = red + 32 * 64;
    constexpr int T_WIN = USE_I8_WIN ? 88 : 0, T_GU = 224, NT = 2 * T_WIN + T_GU;
    for (int task = F.bid; task < NT; task += F.G) {
        int tid = F.tid; asm volatile("" : "+v"(tid));
        const int lane = tid & 63, wave = __builtin_amdgcn_readfirstlane(tid >> 6);
        const float* src; int ld, nvalid; unsigned char* dst; unsigned* cm;
        if (task < 2 * T_WIN) { const int l = task / T_WIN, n0 = 64 * (task % T_WIN); const int col = n0 < 4096 ? n0 : (n0 < 5376 ? n0 + 16 : 4096); nvalid = n0 < 5376 ? 64 : (n0 == 5376 ? 16 : 0);
            src = A.in[IN_WIN] + (size_t)l * DM * DIN + col; ld = DIN; dst = F.ws + WS_WIN + l * WIN_BYTES + (size_t)n0 * DM; cm = ctl + CW_COLMAX + l * DINP + n0; }
        else { const int n0 = 64 * (task - 2 * T_WIN), tile = n0 >> 8, within = n0 & 255; nvalid = 64;
            src = (within < 128 ? A.in[IN_FWG] : A.in[IN_FWU]) + 128 * tile + (within & 127); ld = DFF; dst = F.ws + WS_FGU + (size_t)n0 * DM; cm = ctl + CW_COLMAX + 2 * DINP + n0; }
        { const int c4 = tid & 15, rg = tid >> 4; const bool ok = 4 * c4 < nvalid; const float* p = src + (size_t)rg * ld + (ok ? 4 * c4 : 0);
          f32x4 m = (f32x4){0.f, 0.f, 0.f, 0.f};
#pragma unroll 16
          for (int i = 0; i < 64; ++i) { const f32x4 v = *(const f32x4*)(p + (size_t)(32 * i) * ld); m[0] = fmaxf(m[0], fabsf(v[0])); m[1] = fmaxf(m[1], fabsf(v[1])); m[2] = fmaxf(m[2], fabsf(v[2])); m[3] = fmaxf(m[3], fabsf(v[3])); }
          __syncthreads();
          *(LAS f32x4*)(red + rg * 64 + 4 * c4) = ok ? m : (f32x4){0.f, 0.f, 0.f, 0.f};
          __syncthreads();
          if (tid < 64) { float mx = 0.f;
#pragma unroll
              for (int g = 0; g < 32; ++g) mx = fmaxf(mx, red[g * 64 + tid]);
              cmax[tid] = mx; cm[tid] = __float_as_uint(mx); }
          __syncthreads(); }
        for (int it = wave; it < 32; it += NWAVES) { const int kb = it >> 1, nh = it & 1;
            const int q = lane >> 3, c = lane & 7; const bool ok = 32 * nh + 4 * c < nvalid;
            const float* p = src + (size_t)(128 * kb + 4 * q) * ld + (ok ? 32 * nh + 4 * c : 0);
            f32x4 v[16];
#pragma unroll
            for (int i = 0; i < 4; ++i)
#pragma unroll
                for (int kk = 0; kk < 4; ++kk) v[4 * i + kk] = *(const f32x4*)(p + (size_t)(32 * i + kk) * ld);
            float s4[4];
#pragma unroll
            for (int j = 0; j < 4; ++j) { const float mxc = cmax[32 * nh + 4 * c + j]; s4[j] = (ok && mxc > 0.f) ? 127.0f / mxc : 0.f; }
#pragma unroll
            for (int i = 0; i < 4; ++i)
#pragma unroll
                for (int j = 0; j < 4; ++j) scr[(4 * c + j) * 33 + q + 8 * i] = cvt4_i8(v[4 * i][j] * s4[j], v[4 * i + 1][j] * s4[j], v[4 * i + 2][j] * s4[j], v[4 * i + 3][j] * s4[j]);
            LDS_WAIT(); asm volatile("" ::: "memory");
            const int ch = lane & 7;
#pragma unroll
            for (int m = 0; m < 4; ++m) { const int n = (lane >> 3) + 8 * m; const LAS unsigned* sp = scr + n * 33 + 4 * ch;
                u32x4 o; o.x = sp[0]; o.y = sp[1]; o.z = sp[2]; o.w = sp[3]; *(u32x4*)(dst + (size_t)(32 * nh + n) * DM + 128 * kb + 16 * ch) = o; }
            LDS_WAIT(); asm volatile("" ::: "memory"); }
    }
    __syncthreads();
}
__device__ __forceinline__ void p0_s5tab(const Args& A, const Frame& F) {
    float* tab = (float*)(F.ws + WS_S5TAB);
    for (int i = F.gt; i < 2 * 32 * 64; i += F.ngt) {
        const int lg = i >> 6;
        const float dt = expf(A.in[IN_LOGDT][lg]);
        const float lr = fminf(A.in[IN_LAMRE][i], -1e-4f), li = A.in[IN_LAMIM][i];
        const float mag = expf(lr * dt), ab_re = mag * cosf(li * dt), ab_im = mag * sinf(li * dt);
        const float den = lr * lr + li * li, nr = ab_re - 1.0f;
        const float coef_re = (nr * lr + ab_im * li) / den, coef_im = (ab_im * lr - nr * li) / den;
        float* t = tab + (size_t)i * 36; t[0] = ab_re; t[1] = ab_im; t[2] = 0.f; t[3] = 0.f;
        for (int h = 0; h < 16; ++h) { const float br = A.in[IN_BRE][(size_t)i * 16 + h], bi = A.in[IN_BIM][(size_t)i * 16 + h];
            t[4 + h] = coef_re * br - coef_im * bi; t[20 + h] = coef_re * bi + coef_im * br; }
    }
}

__device__ __forceinline__ void ld_row_f32(const float* p, int lane, f32x4 (&v)[8]) {
#pragma unroll
    for (int j = 0; j < 8; ++j) v[j] = ((const f32x4*)p)[64 * j + lane];
}
__device__ __forceinline__ void ld_row_bf16(const bf16* p, int lane, f32x4 (&v)[8]) {
#pragma unroll
    for (int j = 0; j < 8; ++j) { const u32x2 w = ((const u32x2*)p)[64 * j + lane]; v[j] = (f32x4){bflo(w.x), bfhi(w.x), bflo(w.y), bfhi(w.y)}; }
}
__device__ __forceinline__ void st_row_bf16(bf16* p, int lane, const f32x4 (&v)[8]) {
#pragma unroll
    for (int j = 0; j < 8; ++j) { u32x2 w; w.x = pk2(v[j][0], v[j][1]); w.y = pk2(v[j][2], v[j][3]); ((u32x2*)p)[64 * j + lane] = w; }
}
__device__ __forceinline__ void st_row_fp8(unsigned char* p, int lane, const f32x4 (&v)[8], float s) {
#pragma unroll
    for (int j = 0; j < 8; ++j) ((unsigned*)p)[64 * j + lane] = pg8::cvt4_fp8(v[j][0] * s, v[j][1] * s, v[j][2] * s, v[j][3] * s);
}
__device__ __forceinline__ void st_row_f32(float* p, int lane, const f32x4 (&v)[8]) {
#pragma unroll
    for (int j = 0; j < 8; ++j) ((f32x4*)p)[64 * j + lane] = v[j];
}
__device__ __forceinline__ float row_sumsq(const f32x4 (&v)[8]) {
    float s = 0.f;
#pragma unroll
    for (int j = 0; j < 8; ++j) s += (v[j][0] * v[j][0] + v[j][1] * v[j][1]) + (v[j][2] * v[j][2] + v[j][3] * v[j][3]);
    return wave_sum(s);
}
__device__ __forceinline__ void st_row_i8(unsigned char* p, float* rowscale, int lane, const f32x4 (&x)[8]) {
    float mx = 0.f;
#pragma unroll
    for (int j = 0; j < 8; ++j) mx = fmaxf(fmaxf(mx, fmaxf(fabsf(x[j][0]), fabsf(x[j][1]))), fmaxf(fabsf(x[j][2]), fabsf(x[j][3])));
#pragma unroll
    for (int o = 1; o < 64; o <<= 1) mx = fmaxf(mx, __shfl_xor(mx, o));
    mx = fmaxf(mx, 1e-20f); const float sq = 127.0f / mx;
#pragma unroll
    for (int j = 0; j < 8; ++j) ((unsigned*)p)[64 * j + lane] = cvt4_i8(x[j][0] * sq, x[j][1] * sq, x[j][2] * sq, x[j][3] * sq);
    if (lane == 0) *rowscale = mx * (1.0f / 127.0f);
}
__device__ __forceinline__ void rp_norm1(const Args& A, const Frame& F, const float* x, const float* gain, bf16* hn) {
    for (int m = F.gw; m < NTOK; m += F.ngw) {
        f32x4 v[8], g[8]; ld_row_f32(x + (size_t)m * DM, F.lane, v); ld_row_f32(gain, F.lane, g);
        const float rstd = rsqrtf(row_sumsq(v) * (1.0f / DM) + EPS);
#pragma unroll
        for (int j = 0; j < 8; ++j) v[j] = v[j] * rstd * g[j];
        if (USE_I8_WIN) st_row_i8((unsigned char*)hn + (size_t)m * DM, (float*)(F.ws + WS_MISC) + MI_ROWSC + m, F.lane, v);
        else st_row_bf16(hn + (size_t)m * DM, F.lane, v);
    }
}
__device__ __forceinline__ void rp_post_mixer(const Args& A, const Frame& F, const float* xsrc, const bf16* mix, const float* g1, const float* g2, bf16* hn, bool moe, const float* wr) {
    unsigned* ctl = (unsigned*)(F.ws + WS_CTL); int* misc = (int*)(F.ws + WS_MISC);
    LAS float* wt = (LAS float*)F.lds;
    if (moe) {
        for (int i = F.tid; i < DM * 2; i += NTHR) { const int k = i >> 1, hf = i & 1; const f32x4 w4 = *(const f32x4*)(wr + (size_t)k * 8 + 4 * hf);
            wt[(4 * hf + 0) * DM + k] = w4[0]; wt[(4 * hf + 1) * DM + k] = w4[1]; wt[(4 * hf + 2) * DM + k] = w4[2]; wt[(4 * hf + 3) * DM + k] = w4[3]; }
        __syncthreads(); }
    for (int m = F.gw; m < NTOK; m += F.ngw) {
        f32x4 v[8], x[8], g[8]; ld_row_bf16(mix + (size_t)m * DM, F.lane, v); ld_row_f32(xsrc + (size_t)m * DM, F.lane, x); ld_row_f32(g1, F.lane, g);
        const float r1 = rsqrtf(row_sumsq(v) * (1.0f / DM) + EPS);
#pragma unroll
        for (int j = 0; j < 8; ++j) x[j] = x[j] + v[j] * r1 * g[j];
        st_row_f32(F.out + (size_t)m * DM, F.lane, x);
        ld_row_f32(g2, F.lane, g);
        const float r2 = rsqrtf(row_sumsq(x) * (1.0f / DM) + EPS);
#pragma unroll
        for (int j = 0; j < 8; ++j) x[j] = x[j] * r2 * g[j];
        if (USE_FP8 && (moe || FP8_E0 == 0)) st_row_fp8((unsigned char*)hn + (size_t)m * DM, F.lane, x, F8_SA);
        else if (USE_I8) {
            float mx = 0.f;
#pragma unroll
            for (int j = 0; j < 8; ++j) mx = fmaxf(fmaxf(mx, fmaxf(fabsf(x[j][0]), fabsf(x[j][1]))), fmaxf(fabsf(x[j][2]), fabsf(x[j][3])));
#pragma unroll
            for (int o = 1; o < 64; o <<= 1) mx = fmaxf(mx, __shfl_xor(mx, o));
            mx = fmaxf(mx, 1e-20f); const float sq = 127.0f / mx;
#pragma unroll
            for (int j = 0; j < 8; ++j) ((unsigned*)((unsigned char*)hn + (size_t)m * DM))[64 * j + F.lane] = cvt4_i8(x[j][0] * sq, x[j][1] * sq, x[j][2] * sq, x[j][3] * sq);
            if (F.lane == 0) ((float*)misc)[MI_ROWSC + m] = mx * (1.0f / 127.0f); }
        else st_row_bf16(hn + (size_t)m * DM, F.lane, x);
        if (moe) {
            float lg[8];
#pragma unroll
            for (int e = 0; e < 8; ++e) lg[e] = 0.f;
#pragma unroll
            for (int j = 0; j < 8; ++j) { asm volatile("" ::: "memory");
#pragma unroll
                for (int e = 0; e < 8; ++e) { const f32x4 w4 = *(const LAS f32x4*)(wt + e * DM + 256 * j + 4 * F.lane);
                    lg[e] += (x[j][0] * w4[0] + x[j][1] * w4[1]) + (x[j][2] * w4[2] + x[j][3] * w4[3]); } }
#pragma unroll
            for (int e = 0; e < 8; ++e) lg[e] = wave_sum(lg[e]);
            int e1 = 0; float v1 = lg[0];
#pragma unroll
            for (int e = 1; e < 8; ++e) if (lg[e] > v1) { v1 = lg[e]; e1 = e; }
            int e2 = -1; float v2 = -3.0e38f;
#pragma unroll
            for (int e = 0; e < 8; ++e) if (e != e1 && lg[e] > v2) { v2 = lg[e]; e2 = e; }
            if (F.lane == 0) {
                const float ga = 1.0f / (1.0f + expf(v2 - v1));
                const int p1 = (int)atomicAdd(ctl + CW_CNT + 64 * e1, 1u), p2 = (int)atomicAdd(ctl + CW_CNT + 64 * e2, 1u);
                misc[MI_ROUTE + 4 * m + 0] = e1; misc[MI_ROUTE + 4 * m + 1] = e2; misc[MI_ROUTE + 4 * m + 2] = p1; misc[MI_ROUTE + 4 * m + 3] = p2;
                ((float*)misc)[MI_GATE + 2 * m + 0] = ga; ((float*)misc)[MI_GATE + 2 * m + 1] = 1.0f - ga;
            }
        }
    }
}
__device__ __forceinline__ void moe_dispatch(const Args& A, const Frame& F, const bf16* hn) {
    unsigned* ctl = (unsigned*)(F.ws + WS_CTL); int* misc = (int*)(F.ws + WS_MISC);
    LAS int* tb = (LAS int*)(F.lds);
    if (F.tid == 0) { int off = 0; for (int e = 0; e < 8; ++e) { const int c = (int)__hip_atomic_load(ctl + CW_CNT + 64 * e, __ATOMIC_RELAXED, __HIP_MEMORY_SCOPE_AGENT); const int t = (c + 255) >> 8; tb[e] = c; tb[8 + e] = off * 256; tb[16 + e] = t * 256;
            if (F.bid == 0) for (int i = 0; i < t; ++i) misc[MI_TILEE + off + i] = e;
            off += t; }
        if (F.bid == 0) misc[MI_NTILES] = off; }
    __syncthreads();
    constexpr int RB = USE_FP8 ? DM : 2 * DM, NV = RB / 1024;
    unsigned char* xg = F.ws + WS_XG;
    for (int m = F.gw; m < NTOK; m += F.ngw) {
        const int e1 = misc[MI_ROUTE + 4 * m], e2 = misc[MI_ROUTE + 4 * m + 1], p1 = misc[MI_ROUTE + 4 * m + 2], p2 = misc[MI_ROUTE + 4 * m + 3];
        const int r1 = tb[8 + e1] + p1, r2 = tb[8 + e2] + p2;
        if (F.lane == 0) { misc[MI_ROWS + 2 * m] = r1; misc[MI_ROWS + 2 * m + 1] = r2; }
        const u32x4* s = (const u32x4*)((const unsigned char*)hn + (size_t)m * RB); u32x4* d1 = (u32x4*)(xg + (size_t)r1 * RB); u32x4* d2 = (u32x4*)(xg + (size_t)r2 * RB);
#pragma unroll
        for (int j = 0; j < NV; ++j) { const u32x4 w = s[64 * j + F.lane]; d1[64 * j + F.lane] = w; d2[64 * j + F.lane] = w; }
    }
    for (int i = F.gw; i < 8 * 256; i += F.ngw) { const int e = i >> 8, r = tb[e] + (i & 255);
        if (r < tb[16 + e]) { u32x4* d = (u32x4*)(xg + (size_t)(tb[8 + e] + r) * RB);
#pragma unroll
            for (int j = 0; j < NV; ++j) d[64 * j + F.lane] = (u32x4){0u, 0u, 0u, 0u}; } }
    __syncthreads();
}
__device__ __forceinline__ void rp_post_ffn(const Args& A, const Frame& F, const bf16* fo, bool moe, const float* g3, const float* g0n, bf16* hn) {
    const int* misc = (const int*)(F.ws + WS_MISC);
    for (int m = F.gw; m < NTOK; m += F.ngw) {
        f32x4 v[8], x[8], g[8];
        if (moe) { const int r1 = misc[MI_ROWS + 2 * m], r2 = misc[MI_ROWS + 2 * m + 1]; const float ga = ((const float*)misc)[MI_GATE + 2 * m], gb = ((const float*)misc)[MI_GATE + 2 * m + 1];
            if (r1 < 256 * YP_NF && r2 < 256 * YP_NF) { ld_row_bf16(fo + (size_t)r1 * DM, F.lane, v); ld_row_bf16(fo + (size_t)r2 * DM, F.lane, x);
#pragma unroll
                for (int j = 0; j < 8; ++j) v[j] = v[j] * ga + x[j] * gb; }
            else {
                const float* yp = (const float*)(F.ws + WS_YP);
#pragma unroll
                for (int which = 0; which < 2; ++which) { const int rr = which ? r2 : r1; f32x4 (&d)[8] = which ? x : v;
                    if (rr < 256 * YP_NF) ld_row_bf16(fo + (size_t)rr * DM, F.lane, d);
                    else { ld_row_f32(yp + (size_t)(rr - 256 * YP_NF) * DM, F.lane, d);
                        for (int s = 1; s < 4; ++s) { ld_row_f32(yp + s * YP_SLICE + (size_t)(rr - 256 * YP_NF) * DM, F.lane, g);
#pragma unroll
                            for (int j = 0; j < 8; ++j) d[j] = d[j] + g[j]; }
#pragma unroll
                        for (int j = 0; j < 8; ++j) { const unsigned w0 = pk2(d[j][0], d[j][1]), w1 = pk2(d[j][2], d[j][3]); d[j] = (f32x4){bflo(w0), bfhi(w0), bflo(w1), bfhi(w1)}; } } }
#pragma unroll
                for (int j = 0; j < 8; ++j) v[j] = v[j] * ga + x[j] * gb; } }
        else ld_row_bf16(fo + (size_t)m * DM, F.lane, v);
        ld_row_f32(F.out + (size_t)m * DM, F.lane, x); ld_row_f32(g3, F.lane, g);
        const float r1 = rsqrtf(row_sumsq(v) * (1.0f / DM) + EPS);
#pragma unroll
        for (int j = 0; j < 8; ++j) x[j] = x[j] + v[j] * r1 * g[j];
        st_row_f32(F.out + (size_t)m * DM, F.lane, x);
        if (g0n) { ld_row_f32(g0n, F.lane, g); const float r2 = rsqrtf(row_sumsq(x) * (1.0f / DM) + EPS);
#pragma unroll
            for (int j = 0; j < 8; ++j) x[j] = x[j] * r2 * g[j];
            if (USE_I8_WIN) st_row_i8((unsigned char*)hn + (size_t)m * DM, (float*)(F.ws + WS_MISC) + MI_ROWSC + m, F.lane, x);
            else st_row_bf16(hn + (size_t)m * DM, F.lane, x); }
    }
}
#define XB_TMO      128
#define XB_XCNT(j)  (256  + 64 * (j))
#define XB_XSUB(j)  (1280 + 64 * (j))
#define XB_XGEN(j)  (2304 + 64 * (j))
#define XB_TOP      3328
#define XB_TOPGEN   3392
#define XCD_BAR_WORDS 3456
#define XB_SPIN_CAP (1u << 18)

__device__ __forceinline__ unsigned xb_ld(unsigned* p)              { return __hip_atomic_load(p, __ATOMIC_RELAXED, __HIP_MEMORY_SCOPE_AGENT); }
__device__ __forceinline__ unsigned xb_add(unsigned* p, unsigned v) { return __hip_atomic_fetch_add(p, v, __ATOMIC_RELAXED, __HIP_MEMORY_SCOPE_AGENT); }
__device__ __forceinline__ unsigned xb_xcc_id() { return (unsigned)__builtin_amdgcn_s_getreg((3 << 11) | 20) & 0xFu; }
#define XB_SPIN(cond, bar) do { unsigned _sp = 0; while (cond) { __builtin_amdgcn_s_sleep(1); \
    if ((++_sp & 255u) == 0u) { if (xb_ld(&(bar)[XB_TMO])) break; if (_sp > XB_SPIN_CAP) { atomicAdd(&(bar)[XB_TMO], 1u); break; } } } } while (0)

struct XcdBarrier {
    unsigned* bar; unsigned x;
    volatile LAS unsigned* st;
};

__device__ __forceinline__ XcdBarrier xcd_barrier_post(unsigned* bar, volatile LAS unsigned* st) {
    XcdBarrier b; b.bar = bar; b.x = xb_xcc_id(); b.st = st;
    if (threadIdx.x == 0) (void)xb_add(&bar[XB_XCNT(b.x)], 1u);
    return b;
}
__device__ __forceinline__ void xcd_barrier_complete(unsigned* bar, unsigned x, unsigned& nloc, unsigned& nx) {
    const unsigned G = gridDim.x * gridDim.y * gridDim.z;
    unsigned sum, cnt, mine, sp = 0u;
    for (;;) {
        sum = 0u; cnt = 0u; mine = 0u;
#pragma unroll
        for (unsigned j = 0; j < 16; ++j) { const unsigned c = xb_ld(&bar[XB_XCNT(j)]); sum += c; cnt += (c > 0u) ? 1u : 0u; mine = (j == x) ? c : mine; }
        if (sum == G) break;
        __builtin_amdgcn_s_sleep(1);
        if ((++sp & 255u) == 0u) { if (xb_ld(&bar[XB_TMO])) break; if (sp > XB_SPIN_CAP) { atomicAdd(&bar[XB_TMO], 1u); break; } }
    }
    nloc = mine > 0u ? mine : 1u; nx = cnt > 0u ? cnt : 1u;
}

__device__ __forceinline__ void xcd_barrier(const XcdBarrier& b) {
    asm volatile("s_waitcnt vmcnt(0)" ::: "memory");
    __syncthreads();
    if (threadIdx.x == 0) {
        unsigned* bar = b.bar;
        __builtin_amdgcn_s_waitcnt(0);
        unsigned nloc = b.st[0], nx = b.st[1];
        if (nloc == 0u) { xcd_barrier_complete(bar, b.x, nloc, nx); b.st[0] = nloc; b.st[1] = nx; }
        const unsigned old = xb_add(&bar[XB_XSUB(b.x)], 1u);
        const unsigned gen = old / nloc;
        if (old + 1u == (gen + 1u) * nloc) {
            __builtin_amdgcn_fence(__ATOMIC_RELEASE, "agent");
            asm volatile("s_waitcnt vmcnt(0)" ::: "memory");
            const unsigned og = xb_add(&bar[XB_TOP], 1u);
            const unsigned tg = og / nx;
            if (og + 1u == (tg + 1u) * nx) xb_add(&bar[XB_TOPGEN], 1u);
            else XB_SPIN(xb_ld(&bar[XB_TOPGEN]) == tg, bar);
            __builtin_amdgcn_fence(__ATOMIC_ACQUIRE, "agent");
            xb_add(&bar[XB_XGEN(b.x)], 1u);
            asm volatile("s_waitcnt vmcnt(0)" ::: "memory");
        } else {
            XB_SPIN(xb_ld(&bar[XB_XGEN(b.x)]) == gen, bar);
            __builtin_amdgcn_fence(__ATOMIC_ACQUIRE, "agent");
            asm volatile("s_waitcnt vmcnt(0)" ::: "memory");
        }
    }
    __syncthreads();
}
__device__ __forceinline__ void dn_prep_naive(const Args& A, const Frame& F, int layer) {
    const bf16* proj = (const bf16*)(F.ws + WS_PROJ); float* qkv = (float*)(F.ws + WS_DNQKV); float* gb = (float*)(F.ws + WS_DNGB);
    const float* cw = A.in[IN_CONVW] + (size_t)layer * 4 * 3072;
    for (int it = F.gw; it < NTOK * 8; it += F.ngw) {
        const int n = it >> 3, h = it & 7, l = n & (SEQ - 1);
        float a[3][2];
#pragma unroll
        for (int s = 0; s < 3; ++s) { a[s][0] = 0.f; a[s][1] = 0.f; }
#pragma unroll
        for (int j = 0; j < 4; ++j) { if (l - 3 + j >= 0) { const bf16* row = proj + (size_t)(n - 3 + j) * DINP;
#pragma unroll
                for (int s = 0; s < 3; ++s) { const unsigned w = *(const unsigned*)(row + s * 1024 + h * 128 + 2 * F.lane); const f32x2v c = *(const f32x2v*)(cw + j * 3072 + s * 1024 + h * 128 + 2 * F.lane);
                    a[s][0] += bflo(w) * c.x; a[s][1] += bfhi(w) * c.y; } } }
#pragma unroll
        for (int s = 0; s < 3; ++s) { a[s][0] = siluf(a[s][0]); a[s][1] = siluf(a[s][1]); }
        const float rq = rsqrtf(wave_sum(a[0][0] * a[0][0] + a[0][1] * a[0][1]) + EPS) * 0.08838834764831845f;
        const float rk = rsqrtf(wave_sum(a[1][0] * a[1][0] + a[1][1] * a[1][1]) + EPS);
        float* o = qkv + (size_t)it * 384 + 2 * F.lane;
        *(f32x2v*)(o) = (f32x2v){a[0][0] * rq, a[0][1] * rq}; *(f32x2v*)(o + 128) = (f32x2v){a[1][0] * rk, a[1][1] * rk}; *(f32x2v*)(o + 256) = (f32x2v){a[2][0], a[2][1]};
        if (F.lane == 0) { const float al = bf2f(proj[(size_t)n * DINP + C_AL + h]), be = bf2f(proj[(size_t)n * DINP + C_BE + h]);
            gb[(size_t)it * 2] = -expf(A.in[IN_ALOG][layer * 8 + h]) * softplusf_(al + A.in[IN_DTB][layer * 8 + h]); gb[(size_t)it * 2 + 1] = sigmoidf_(be); }
    }
}
__device__ __forceinline__ void dn_scan_naive(const Args& A, const Frame& F, int tsk) {
    const float* qkv = (const float*)(F.ws + WS_DNQKV); const float* gb = (const float*)(F.ws + WS_DNGB); float* oo = (float*)(F.ws + WS_DNO);
    const int b = tsk >> 5, h = (tsk >> 2) & 7, col = (tsk & 3) * 32 + (F.lane >> 1), half = F.lane & 1;
    float S[64];
#pragma unroll
    for (int m = 0; m < 64; ++m) S[m] = 0.f;
    for (int t = 0; t < SEQ; ++t) {
        const size_t it = (size_t)(b * SEQ + t) * 8 + h; const float* base = qkv + it * 384;
        const float eg = expf(gb[it * 2]), beta = gb[it * 2 + 1];
        const f32x4* kp = (const f32x4*)(base + 128 + 64 * half); const f32x4* qp = (const f32x4*)(base + 64 * half);
        float dot = 0.f;
#pragma unroll
        for (int seg = 0; seg < 4; ++seg) {
#pragma unroll
            for (int m4 = 4 * seg; m4 < 4 * seg + 4; ++m4) { const f32x4 k = kp[m4];
#pragma unroll
                for (int c = 0; c < 4; ++c) { S[4 * m4 + c] *= eg; dot += k[c] * S[4 * m4 + c]; } }
            asm volatile("" ::: "memory"); }
        dot += __shfl_xor(dot, 1);
        const float delta = beta * (base[256 + col] - dot);
        float o = 0.f;
#pragma unroll
        for (int seg = 0; seg < 4; ++seg) {
#pragma unroll
            for (int m4 = 4 * seg; m4 < 4 * seg + 4; ++m4) { const f32x4 k = kp[m4], q = qp[m4];
#pragma unroll
                for (int c = 0; c < 4; ++c) { S[4 * m4 + c] += k[c] * delta; o += q[c] * S[4 * m4 + c]; } }
            asm volatile("" ::: "memory"); }
        o += __shfl_xor(o, 1);
        if (half == 0) oo[(size_t)(b * SEQ + t) * 1024 + h * 128 + col] = o;
    }
}
__device__ __forceinline__ void dn_finalize_naive(const Args& A, const Frame& F, int layer) {
    const bf16* proj = (const bf16*)(F.ws + WS_PROJ); const float* oo = (const float*)(F.ws + WS_DNO); bf16* mc = (bf16*)(F.ws + WS_MIXCAT);
    const f32x2v an = *(const f32x2v*)(A.in[IN_ANORM] + layer * 128 + 2 * F.lane);
    for (int it = F.gw; it < NTOK * 8; it += F.ngw) {
        const int n = it >> 3, h = it & 7;
        const f32x2v o = *(const f32x2v*)(oo + (size_t)n * 1024 + h * 128 + 2 * F.lane);
        const float r = rsqrtf(wave_sum(o.x * o.x + o.y * o.y) * (1.0f / 128.0f) + EPS);
        const unsigned gw = *(const unsigned*)(proj + (size_t)n * DINP + C_GATE + h * 128 + 2 * F.lane);
        *(unsigned*)(mc + (size_t)n * DM + h * 128 + 2 * F.lane) = pk2(o.x * r * an.x * siluf(bflo(gw)), o.y * r * an.y * siluf(bfhi(gw)));
    }
}
__device__ __forceinline__ void swa_naive(const Args& A, const Frame& F, int layer) {
    const bf16* proj = (const bf16*)(F.ws + WS_PROJ); bf16* att = (bf16*)(F.ws + WS_ATT);
    for (int idx = F.gt; idx < NTOK * 8; idx += F.ngt) {
        const int n = idx >> 3, h = idx & 7, b = n >> 12, l = n & (SEQ - 1), c = l >> 6, kvh = h >> 2;
        const int c0 = c >= 2 ? c - 2 : 0, k0 = b * SEQ + c0 * 64, k1 = b * SEQ + (c + 1) * 64;
        const float sink = A.in[IN_SINKS][layer * 8 + h];
        float q[64], o[64];
        { const u32x4* qp = (const u32x4*)(proj + (size_t)n * DINP + C_BQ + h * 64);
#pragma unroll
          for (int i = 0; i < 8; ++i) { const u32x4 w = qp[i]; q[8 * i] = bflo(w.x) * 0.125f; q[8 * i + 1] = bfhi(w.x) * 0.125f; q[8 * i + 2] = bflo(w.y) * 0.125f; q[8 * i + 3] = bfhi(w.y) * 0.125f;
              q[8 * i + 4] = bflo(w.z) * 0.125f; q[8 * i + 5] = bfhi(w.z) * 0.125f; q[8 * i + 6] = bflo(w.w) * 0.125f; q[8 * i + 7] = bfhi(w.w) * 0.125f; } }
        float mx = sink;
        for (int m = k0; m < k1; ++m) { const u32x4* kp = (const u32x4*)(proj + (size_t)m * DINP + C_BK + kvh * 64); float s = 0.f;
#pragma unroll
            for (int i = 0; i < 8; ++i) { const u32x4 w = kp[i]; s += q[8 * i] * bflo(w.x) + q[8 * i + 1] * bfhi(w.x) + q[8 * i + 2] * bflo(w.y) + q[8 * i + 3] * bfhi(w.y) + q[8 * i + 4] * bflo(w.z) + q[8 * i + 5] * bfhi(w.z) + q[8 * i + 6] * bflo(w.w) + q[8 * i + 7] * bfhi(w.w); }
            mx = fmaxf(mx, s); }
        float den = expf(sink - mx);
#pragma unroll
        for (int d = 0; d < 64; ++d) o[d] = 0.f;
        for (int m = k0; m < k1; ++m) { const u32x4* kp = (const u32x4*)(proj + (size_t)m * DINP + C_BK + kvh * 64); const u32x4* vp = (const u32x4*)(proj + (size_t)m * DINP + C_BV + kvh * 64); float s = 0.f;
#pragma unroll
            for (int i = 0; i < 8; ++i) { const u32x4 w = kp[i]; s += q[8 * i] * bflo(w.x) + q[8 * i + 1] * bfhi(w.x) + q[8 * i + 2] * bflo(w.y) + q[8 * i + 3] * bfhi(w.y) + q[8 * i + 4] * bflo(w.z) + q[8 * i + 5] * bfhi(w.z) + q[8 * i + 6] * bflo(w.w) + q[8 * i + 7] * bfhi(w.w); }
            const float p = expf(s - mx); den += p;
#pragma unroll
            for (int i = 0; i < 8; ++i) { const u32x4 w = vp[i]; o[8 * i] += p * bflo(w.x); o[8 * i + 1] += p * bfhi(w.x); o[8 * i + 2] += p * bflo(w.y); o[8 * i + 3] += p * bfhi(w.y); o[8 * i + 4] += p * bflo(w.z); o[8 * i + 5] += p * bfhi(w.z); o[8 * i + 6] += p * bflo(w.w); o[8 * i + 7] += p * bfhi(w.w); } }
        const float inv = 1.0f / den; u32x4* op = (u32x4*)(att + (size_t)n * 512 + h * 64);
#pragma unroll
        for (int i = 0; i < 8; ++i) { u32x4 w; w.x = pk2(o[8 * i] * inv, o[8 * i + 1] * inv); w.y = pk2(o[8 * i + 2] * inv, o[8 * i + 3] * inv); w.z = pk2(o[8 * i + 4] * inv, o[8 * i + 5] * inv); w.w = pk2(o[8 * i + 6] * inv, o[8 * i + 7] * inv); op[i] = w; }
    }
}
__device__ __forceinline__ void s5_scan_naive(const Args& A, const Frame& F, int layer, int tsk) {
    const bf16* proj = (const bf16*)(F.ws + WS_PROJ); f32x2v* xs = (f32x2v*)(F.ws + WS_XS);
    const int b = tsk >> 5, g = tsk & 31, p = F.lane;
    const float* t = (const float*)(F.ws + WS_S5TAB) + (size_t)((layer * 32 + g) * 64 + p) * 36;
    const float ar = t[0], ai = t[1]; float br[16], bi[16];
#pragma unroll
    for (int h = 0; h < 16; ++h) { br[h] = t[4 + h]; bi[h] = t[20 + h]; }
    float xr = 0.f, xi = 0.f;
    for (int s = 0; s < SEQ; ++s) { const int n = b * SEQ + s; const u32x4* up = (const u32x4*)(proj + (size_t)n * DINP + C_CU + g * 16); const u32x4 w0 = up[0], w1 = up[1];
        float u[16]; u[0] = bflo(w0.x); u[1] = bfhi(w0.x); u[2] = bflo(w0.y); u[3] = bfhi(w0.y); u[4] = bflo(w0.z); u[5] = bfhi(w0.z); u[6] = bflo(w0.w); u[7] = bfhi(w0.w);
        u[8] = bflo(w1.x); u[9] = bfhi(w1.x); u[10] = bflo(w1.y); u[11] = bfhi(w1.y); u[12] = bflo(w1.z); u[13] = bfhi(w1.z); u[14] = bflo(w1.w); u[15] = bfhi(w1.w);
        float bur = 0.f, bui = 0.f;
#pragma unroll
        for (int h = 0; h < 16; ++h) { bur += u[h] * br[h]; bui += u[h] * bi[h]; }
        const float nr = ar * xr - ai * xi + bur, ni = ar * xi + ai * xr + bui; xr = nr; xi = ni;
        xs[((size_t)n * 32 + g) * 64 + p] = (f32x2v){xr, xi}; }
}
__device__ __forceinline__ void s5_out_naive(const Args& A, const Frame& F, int layer) {
    const bf16* proj = (const bf16*)(F.ws + WS_PROJ); const f32x2v* xs = (const f32x2v*)(F.ws + WS_XS); bf16* z = (bf16*)(F.ws + WS_Z);
    for (int idx = F.gt; idx < NTOK * 512; idx += F.ngt) {
        const int n = idx >> 9, gh = idx & 511, g = gh >> 4;
        const float* cr = A.in[IN_CRE] + (size_t)(layer * 512 + gh) * 64; const float* ci = A.in[IN_CIM] + (size_t)(layer * 512 + gh) * 64; const f32x2v* x = xs + ((size_t)n * 32 + g) * 64;
        float y = 0.f;
        for (int p = 0; p < 64; ++p) { const f32x2v xv = x[p]; y += xv.x * cr[p] - xv.y * ci[p]; }
        y += A.in[IN_S5D][layer * 512 + gh] * bf2f(proj[(size_t)n * DINP + C_CU + gh]);
        z[idx] = (bf16)f2bf(gelu_tanh(y));
    }
}
__device__ __forceinline__ void bc_finalize(const Args& A, const Frame& F, int layer, bool do_b, bool do_c) {
    bf16* mc = (bf16*)(F.ws + WS_MIXCAT);
    for (int n = F.gw; n < NTOK; n += F.ngw) {
#pragma unroll
        for (int part = 0; part < 2; ++part) { if (part == 0 ? !do_b : !do_c) continue;
            const bf16* src = (const bf16*)(F.ws + (part == 0 ? WS_ATT : WS_GLU)) + (size_t)n * 512 + 8 * F.lane; const float* gn = A.in[part == 0 ? IN_BNORM : IN_CNORM] + layer * 512 + 8 * F.lane;
            const u32x4 w = *(const u32x4*)src; float v[8]; v[0] = bflo(w.x); v[1] = bfhi(w.x); v[2] = bflo(w.y); v[3] = bfhi(w.y); v[4] = bflo(w.z); v[5] = bfhi(w.z); v[6] = bflo(w.w); v[7] = bfhi(w.w);
            float ss = 0.f;
#pragma unroll
            for (int i = 0; i < 8; ++i) ss += v[i] * v[i];
            const float r = rsqrtf(wave_sum(ss) * (1.0f / 512.0f) + EPS); const f32x4 g0 = *(const f32x4*)gn, g1 = *(const f32x4*)(gn + 4);
            u32x4 o; o.x = pk2(v[0] * r * g0[0], v[1] * r * g0[1]); o.y = pk2(v[2] * r * g0[2], v[3] * r * g0[3]); o.z = pk2(v[4] * r * g1[0], v[5] * r * g1[1]); o.w = pk2(v[6] * r * g1[2], v[7] * r * g1[3]);
            *(u32x4*)(mc + (size_t)n * DM + 1024 + part * 512 + 8 * F.lane) = o; }
    }
}
constexpr int SWA_KSTR = 72, SWA_VSTR = 200;
constexpr int SWA_LDS_K = 0, SWA_LDS_V = 2 * 192 * SWA_KSTR * 2, SWA_LDS_SS = SWA_LDS_V + 2 * 64 * SWA_VSTR * 2;
typedef short bf16x4 __attribute__((ext_vector_type(4)));
__device__ __forceinline__ void swa_mfma(const Args& A, const Frame& F, int layer) {
    const bf16* proj = (const bf16*)(F.ws + WS_PROJ); bf16* mc = (bf16*)(F.ws + WS_MIXCAT);
    LAS bf16* Ks = (LAS bf16*)(F.lds + SWA_LDS_K); LAS bf16* Vs = (LAS bf16*)(F.lds + SWA_LDS_V); LAS float* SS = (LAS float*)(F.lds + SWA_LDS_SS);
    const int h = F.wave, kvh = h >> 2, r = F.lane & 15, q = F.lane >> 4;
    const float sink = A.in[IN_SINKS][layer * 8 + h];
    for (int unit = F.bid; unit < NBATCH * NCHUNK; unit += F.G) {
        const int b = unit >> 6, c = unit & 63, t0 = b * SEQ + c * 64, key0 = t0 - 128;
        const int kvalid0 = c >= 2 ? 0 : (2 - c) * 64;
        __syncthreads();
        for (int pc = F.tid; pc < 2 * 192 * 8; pc += NTHR) {
            const int g8 = pc & 7, key = (pc >> 3) % 192, kv = pc / (192 * 8);
            u32x4 kw = (u32x4){0u, 0u, 0u, 0u}, vw = (u32x4){0u, 0u, 0u, 0u};
            if (key >= kvalid0) { const bf16* row = proj + (size_t)(key0 + key) * DINP; kw = *(const u32x4*)(row + C_BK + kv * 64 + 8 * g8); vw = *(const u32x4*)(row + C_BV + kv * 64 + 8 * g8); }
            *(LAS u32x4*)(Ks + (kv * 192 + key) * SWA_KSTR + 8 * g8) = kw;
            LAS bf16* vd = Vs + (kv * 64 + 8 * g8) * SWA_VSTR + ((((key >> 3) ^ g8) << 3) | (key & 7));
            vd[0 * SWA_VSTR] = (bf16)(vw.x & 0xffffu); vd[1 * SWA_VSTR] = (bf16)(vw.x >> 16); vd[2 * SWA_VSTR] = (bf16)(vw.y & 0xffffu); vd[3 * SWA_VSTR] = (bf16)(vw.y >> 16);
            vd[4 * SWA_VSTR] = (bf16)(vw.z & 0xffffu); vd[5 * SWA_VSTR] = (bf16)(vw.z >> 16); vd[6 * SWA_VSTR] = (bf16)(vw.w & 0xffffu); vd[7 * SWA_VSTR] = (bf16)(vw.w >> 16);
        }
        __syncthreads();
        f32x4 o[4][4];
        float ssq[4];
#pragma unroll
        for (int nt = 0; nt < 4; ++nt) {
            bf16x8 qf[2];
#pragma unroll
            for (int ks = 0; ks < 2; ++ks) qf[ks] = *(const bf16x8*)(proj + (size_t)(t0 + 16 * nt + r) * DINP + C_BQ + h * 64 + 32 * ks + 8 * q);
            f32x4 s[12];
#pragma unroll
            for (int mt = 0; mt < 12; ++mt) { s[mt] = (f32x4){0.f, 0.f, 0.f, 0.f};
#pragma unroll
                for (int ks = 0; ks < 2; ++ks) { const bf16x8 kf = *(const LAS bf16x8*)(Ks + (kvh * 192 + 16 * mt + r) * SWA_KSTR + 32 * ks + 8 * q);
                    s[mt] = __builtin_amdgcn_mfma_f32_16x16x32_bf16(kf, qf[ks], s[mt], 0, 0, 0); } }
            float m = sink;
#pragma unroll
            for (int mt = 0; mt < 12; ++mt) { const bool valid = (16 * mt >= kvalid0);
#pragma unroll
                for (int i = 0; i < 4; ++i) { s[mt][i] = valid ? s[mt][i] * 0.125f : -INFINITY; m = fmaxf(m, s[mt][i]); } }
            m = fmaxf(m, __shfl_xor(m, 16)); m = fmaxf(m, __shfl_xor(m, 32));
            float sum = 0.f;
#pragma unroll
            for (int mt = 0; mt < 12; ++mt)
#pragma unroll
                for (int i = 0; i < 4; ++i) { const float p = __expf(s[mt][i] - m); s[mt][i] = p; sum += p; }
            sum += __shfl_xor(sum, 16); sum += __shfl_xor(sum, 32);
            const float inv = 1.0f / (sum + __expf(sink - m));
#pragma unroll
            for (int mt = 0; mt < 4; ++mt) o[nt][mt] = (f32x4){0.f, 0.f, 0.f, 0.f};
#pragma unroll
            for (int ks = 0; ks < 6; ++ks) {
                u32x4 pw; pw.x = pk2(s[2 * ks][0] * inv, s[2 * ks][1] * inv); pw.y = pk2(s[2 * ks][2] * inv, s[2 * ks][3] * inv);
                pw.z = pk2(s[2 * ks + 1][0] * inv, s[2 * ks + 1][1] * inv); pw.w = pk2(s[2 * ks + 1][2] * inv, s[2 * ks + 1][3] * inv);
                const bf16x8 pf = __builtin_bit_cast(bf16x8, pw);
#pragma unroll
                for (int mt = 0; mt < 4; ++mt) { const int fe = (2 * mt + (r >> 3)) & 7; const LAS bf16* vp = Vs + (kvh * 64 + 16 * mt + r) * SWA_VSTR + 4 * (q & 1);
                    const u32x2 v0 = *(const LAS u32x2*)(vp + 8 * ((4 * ks + (q >> 1)) ^ fe)), v1 = *(const LAS u32x2*)(vp + 8 * ((4 * ks + 2 + (q >> 1)) ^ fe));
                    const u32x4 vw = (u32x4){v0.x, v0.y, v1.x, v1.y};
                    o[nt][mt] = __builtin_amdgcn_mfma_f32_16x16x32_bf16(__builtin_bit_cast(bf16x8, vw), pf, o[nt][mt], 0, 0, 0); }
            }
            float ss = 0.f;
#pragma unroll
            for (int mt = 0; mt < 4; ++mt)
#pragma unroll
                for (int i = 0; i < 4; ++i) ss += o[nt][mt][i] * o[nt][mt][i];
            ss += __shfl_xor(ss, 16); ss += __shfl_xor(ss, 32);
            ssq[nt] = ss;
            if (q == 0) SS[h * 64 + 16 * nt + r] = ss;
        }
        __syncthreads();
        const float* bn = A.in[IN_BNORM] + layer * 512 + h * 64;
#pragma unroll
        for (int nt = 0; nt < 4; ++nt) {
            float tot = 0.f;
#pragma unroll
            for (int hh = 0; hh < 8; ++hh) tot += SS[hh * 64 + 16 * nt + r];
            const float rs = rsqrtf(tot * (1.0f / 512.0f) + EPS);
#pragma unroll
            for (int mt = 0; mt < 4; ++mt) { const f32x4 g = *(const f32x4*)(bn + 16 * mt + 4 * q); const f32x4 v = o[nt][mt];
                u32x2 w; w.x = pk2(v[0] * rs * g[0], v[1] * rs * g[1]); w.y = pk2(v[2] * rs * g[2], v[3] * rs * g[3]);
                *(u32x2*)(mc + (size_t)(t0 + 16 * nt + r) * DM + 1024 + h * 64 + 16 * mt + 4 * q) = w; }
        }
        (void)ssq;
    }
}
typedef float f32x2p __attribute__((ext_vector_type(2)));
constexpr int S5_BSTR = 20;
constexpr int S5_XSTR = 136;
constexpr int S5_WAVE_LDS = 128 * S5_BSTR * 4 + 16 * S5_XSTR * 2;
template <bool WITH_OUT>
__device__ __forceinline__ void s5_chunk(const Args& A, const Frame& F, int layer, int gw, int ngw) {
    const bf16* proj = (const bf16*)(F.ws + WS_PROJ); f32x2v* Eg = (f32x2v*)(F.ws + WS_S5E); bf16* zb = (bf16*)(F.ws + WS_Z);
    LAS float* Bu = (LAS float*)(F.lds + F.wave * S5_WAVE_LDS); LAS bf16* Xb = (LAS bf16*)(F.lds + F.wave * S5_WAVE_LDS + 128 * S5_BSTR * 4);
    const int r = F.lane & 15, q = F.lane >> 4, p = F.lane;
    __syncthreads();
    int gcur = -1; float ar = 0.f, ai = 0.f, a64r = 0.f, a64i = 0.f; bf16x4 bbf[8]; bf16x8 cmf[4]; f32x4 dv = (f32x4){0.f, 0.f, 0.f, 0.f};
    for (int task = gw; task < NBATCH * 32 * NCHUNK; task += ngw) {
        const int c = task & 63, g = (task >> 6) & 31, b = task >> 11, t0 = b * SEQ + c * 64;
        u32x2 uall[4];
#pragma unroll
        for (int mt = 0; mt < 4; ++mt) uall[mt] = *(const u32x2*)(proj + (size_t)(t0 + 16 * mt + r) * DINP + C_CU + 16 * g + 4 * q);
        if (g != gcur) { gcur = g;
            const float* tab = (const float*)(F.ws + WS_S5TAB) + (size_t)((layer * 32 + g) * 64) * 36;
            ar = tab[p * 36]; ai = tab[p * 36 + 1];
#pragma unroll
            for (int nt = 0; nt < 8; ++nt) { const f32x4 v = *(const f32x4*)(tab + (size_t)((16 * nt + r) & 63) * 36 + 4 + 16 * (nt >> 2) + 4 * q);
                u32x2 w; w.x = pk2(v[0], v[1]); w.y = pk2(v[2], v[3]); bbf[nt] = __builtin_bit_cast(bf16x4, w); }
            if (WITH_OUT) {
#pragma unroll
                for (int ks = 0; ks < 4; ++ks) { const float* src = (ks < 2 ? A.in[IN_CRE] : A.in[IN_CIM]) + (size_t)((layer * 32 + g) * 16 + r) * 64 + 32 * (ks & 1) + 8 * q; const float sg = ks < 2 ? 1.f : -1.f;
                    const f32x4 v0 = *(const f32x4*)src, v1 = *(const f32x4*)(src + 4);
                    u32x4 w; w.x = pk2(sg * v0[0], sg * v0[1]); w.y = pk2(sg * v0[2], sg * v0[3]); w.z = pk2(sg * v1[0], sg * v1[1]); w.w = pk2(sg * v1[2], sg * v1[3]); cmf[ks] = __builtin_bit_cast(bf16x8, w); }
                dv = *(const f32x4*)(A.in[IN_S5D] + (layer * 32 + g) * 16 + 4 * q);
                a64r = ar; a64i = ai;
#pragma unroll
                for (int i = 0; i < 6; ++i) { const float nr = a64r * a64r - a64i * a64i, ni = 2.f * a64r * a64i; a64r = nr; a64i = ni; }
            } }
        float xr = 0.f, xi = 0.f;
        if (WITH_OUT) {
            const f32x2v* Ep = Eg + (size_t)(task - c) * 64 + p;
            for (int cc0 = 0; cc0 < c; cc0 += 16) {
                f32x2v e[16];
#pragma unroll
                for (int k = 0; k < 16; ++k) e[k] = Ep[(size_t)(cc0 + k < c ? cc0 + k : c - 1) * 64];
#pragma unroll
                for (int k = 0; k < 16; ++k) if (cc0 + k < c) { const float nr = a64r * xr - a64i * xi + e[k].x, ni = a64r * xi + a64i * xr + e[k].y; xr = nr; xi = ni; } }
        }
        f32x2p xv = (f32x2p){xr, xi}; const f32x2p a1v = (f32x2p){ar, ar}, a2v = (f32x2p){-ai, ai};
#pragma unroll
        for (int mt = 0; mt < 4; ++mt) {
            const u32x2 uw = uall[mt];
            const bf16x4 uf = __builtin_bit_cast(bf16x4, uw);
#pragma unroll
            for (int nt = 0; nt < 8; ++nt) { f32x4 d = (f32x4){0.f, 0.f, 0.f, 0.f}; d = __builtin_amdgcn_mfma_f32_16x16x16bf16_1k(uf, bbf[nt], d, 0, 0, 0);
                *(LAS f32x4*)(Bu + (16 * nt + r) * S5_BSTR + 4 * q) = d; }
            LDS_WAIT(); asm volatile("" ::: "memory");
            f32x4 bre[4], bim[4];
#pragma unroll
            for (int k4 = 0; k4 < 4; ++k4) { bre[k4] = *(const LAS f32x4*)(Bu + p * S5_BSTR + 4 * k4); bim[k4] = *(const LAS f32x4*)(Bu + (64 + p) * S5_BSTR + 4 * k4); }
#pragma unroll
            for (int t = 0; t < 16; ++t) {
                f32x2p nb = (f32x2p){bre[t >> 2][t & 3], bim[t >> 2][t & 3]};
                asm("v_pk_fma_f32 %0, %1, %2, %0" : "+v"(nb) : "v"(a1v), "v"(xv));
                asm("v_pk_fma_f32 %0, %1, %2, %0 op_sel:[0,1,0] op_sel_hi:[1,0,1]" : "+v"(nb) : "v"(a2v), "v"(xv));
                xv = nb;
                if (WITH_OUT) { const unsigned w = pk2(xv[0], xv[1]); Xb[t * S5_XSTR + p] = (bf16)(w & 0xffffu); Xb[t * S5_XSTR + 64 + p] = (bf16)(w >> 16); } }
            LDS_WAIT(); asm volatile("" ::: "memory");
            if (WITH_OUT) {
                f32x4 y = (f32x4){0.f, 0.f, 0.f, 0.f};
#pragma unroll
                for (int ks = 0; ks < 4; ++ks) { const bf16x8 xf = *(const LAS bf16x8*)(Xb + r * S5_XSTR + 32 * ks + 8 * q); y = __builtin_amdgcn_mfma_f32_16x16x32_bf16(cmf[ks], xf, y, 0, 0, 0); }
                const float u0 = bflo(uw.x), u1 = bfhi(uw.x), u2 = bflo(uw.y), u3 = bfhi(uw.y);
                u32x2 w; w.x = pk2(gelu_tanh(y[0] + dv[0] * u0), gelu_tanh(y[1] + dv[1] * u1)); w.y = pk2(gelu_tanh(y[2] + dv[2] * u2), gelu_tanh(y[3] + dv[3] * u3));
                *(u32x2*)(zb + (size_t)(t0 + 16 * mt + r) * 512 + 16 * g + 4 * q) = w;
                LDS_WAIT(); asm volatile("" ::: "memory");
            }
        }
        if (!WITH_OUT) Eg[(size_t)task * 64 + p] = (f32x2v){xv[0], xv[1]};
    }
}
constexpr int DNL_QN = 0, DNL_KN = 17408, DNL_VT = 34816, DNL_KT = 53248, DNL_KDT = 71680, DNL_LM = 90112, DNL_AT = 107520, DNL_SM = 116736, DNL_CW = 117760;
constexpr int DN_RS = 136, DN_TS = 72, DN_LS = 68;
constexpr size_t WS_DNW = WS_R + 352 * MiB;
constexpr size_t WS_DNN = WS_R + 416 * MiB;
constexpr size_t WS_DNQ = WS_R + 480 * MiB;
constexpr size_t WS_DNOL = WS_R + 512 * MiB;
constexpr size_t WS_DNS = WS_R + 544 * MiB;
constexpr size_t WS_DNEG = WS_R + 608 * MiB;
__device__ __forceinline__ int dn_pos(int d) { const int ks = d >> 5, w = d & 31, sub = w >> 4, qq = (w >> 2) & 3, i = w & 3; return 32 * ks + 8 * qq + 4 * sub + i; }

__device__ __forceinline__ void dn_fmac(float& acc, float a, float b) { asm("v_fmac_f32 %0, %1, %2" : "+v"(acc) : "v"(a), "v"(b)); }
typedef float f32x2p __attribute__((ext_vector_type(2)));
__device__ __forceinline__ void dn_pkfma(f32x2p& acc, f32x2p a, f32x2p b) { asm("v_pk_fma_f32 %0, %1, %2, %0" : "+v"(acc) : "v"(a), "v"(b)); }
template <int I> struct DnSolveRow { static __device__ __forceinline__ void run(f32x2p (&xp)[16], const LAS float* LMp, int par) {
    DnSolveRow<I - 1>::run(xp, LMp, par);
    constexpr int NJ = (I + 3) / 4, NG = (NJ + 1) / 2; f32x2p a01 = (f32x2p){0.f, 0.f}, a23 = (f32x2p){0.f, 0.f};
    f32x4 l[NG];
#pragma unroll
    for (int g = 0; g < NG; ++g) l[g] = *(const LAS f32x4*)(LMp + I * DN_LS + 8 * g);
#pragma unroll
    for (int g = 0; g < NG; ++g) { dn_pkfma(a01, __builtin_shufflevector(l[g], l[g], 0, 1), xp[2 * g]); dn_pkfma(a23, __builtin_shufflevector(l[g], l[g], 2, 3), xp[2 * g + 1]); }
    f32x2p s01; asm("v_pk_add_f32 %0, %1, %2" : "=v"(s01) : "v"(a01), "v"(a23)); float part; asm("v_add_f32 %0, %1, %2" : "=v"(part) : "v"(s01[0]), "v"(s01[1]));
    const float tot = part + __builtin_bit_cast(float, __builtin_amdgcn_update_dpp(0, __builtin_bit_cast(int, part), 0xB1, 0xF, 0xF, false));
    constexpr int OWN = (I >> 2) & 1, SLOT = 4 * (I >> 3) + (I & 3);
    xp[SLOT >> 1][SLOT & 1] = (par == OWN) ? xp[SLOT >> 1][SLOT & 1] - tot : xp[SLOT >> 1][SLOT & 1];
    asm volatile("" ::: "memory"); } };
template <> struct DnSolveRow<0> { static __device__ __forceinline__ void run(f32x2p (&)[16], const LAS float*, int) {} };

#ifndef REP_DN1
#define REP_DN1 1
#endif
#ifndef REP_DN3
#define REP_DN3 1
#endif
#ifndef REP_DN5
#define REP_DN5 1
#endif
#ifndef REP_DN4
#define REP_DN4 1
#endif
template <int FAKE = 0> __device__ __forceinline__ void dn_chunk_prep(const Args& A, const Frame& F, int layer) {
    const bf16* proj = (const bf16*)(F.ws + WS_PROJ);
    const int upw = (NBATCH * 8 * NCHUNK + F.G - 1) / F.G; int hcur = -1;
    const int ubeg = F.bid * upw, uend = ((F.bid + 1) * upw < NBATCH * 8 * NCHUNK) ? (F.bid + 1) * upw : NBATCH * 8 * NCHUNK;
    u32x4 xr[4][3][2]; unsigned abw = 0u;
#define DN_PREFETCH(uo2_, tidp_) do { const int u2_ = (uo2_) < uend ? (uo2_) : uend - 1; const int h2_ = u2_ >> 8, c2_ = u2_ & 63, b2_ = (u2_ >> 6) & 3, t2_ = (tidp_) >> 3, s2_ = (tidp_) & 7, n2_ = b2_ * SEQ + c2_ * 64 + t2_; \
        _Pragma("unroll") for (int j = 0; j < 4; ++j) { const bool vj_ = (c2_ * 64 + t2_ - 3 + j) >= 0; const bf16* row_ = FAKE == 1 ? proj + 16 * s2_ : proj + (size_t)(vj_ ? n2_ - 3 + j : n2_) * DINP + h2_ * 128 + 16 * s2_; \
            _Pragma("unroll") for (int s = 0; s < 3; ++s) { xr[j][s][0] = *(const u32x4*)(row_ + s * 1024); xr[j][s][1] = *(const u32x4*)(row_ + s * 1024 + 8); } } \
        abw = (unsigned)proj[(size_t)n2_ * DINP + C_AL + h2_] | ((unsigned)proj[(size_t)n2_ * DINP + C_BE + h2_] << 16); } while (0)
    if (ubeg < uend) { int tid0 = F.tid; asm volatile("" : "+v"(tid0)); DN_PREFETCH(ubeg, tid0); }
    for (int uo = ubeg; uo < uend; ++uo) {
        const int h = uo >> 8, c = uo & 63, b = (uo >> 6) & 3, unit = (b << 9) | (h << 6) | c, t0 = b * SEQ + c * 64;
        int tid = F.tid; asm volatile("" : "+v"(tid));
        const int r = tid & 15, q = (tid >> 4) & 3, w = __builtin_amdgcn_readfirstlane(tid >> 6), lane = tid & 63;
        LAS bf16* QN = (LAS bf16*)(F.lds + DNL_QN); LAS bf16* KN = (LAS bf16*)(F.lds + DNL_KN); LAS bf16* VT = (LAS bf16*)(F.lds + DNL_VT); LAS bf16* KT = (LAS bf16*)(F.lds + DNL_KT);
        LAS bf16* KDT = (LAS bf16*)(F.lds + DNL_KDT); LAS float* LM = (LAS float*)(F.lds + DNL_LM); LAS bf16* AT = (LAS bf16*)(F.lds + DNL_AT); LAS float* gsh = (LAS float*)(F.lds + DNL_SM);
        asm volatile("" : "+v"(QN), "+v"(KN), "+v"(VT), "+v"(KT), "+v"(KDT), "+v"(LM), "+v"(AT), "+v"(gsh));
        LAS float* bsh = gsh + 64; LAS float* gcs = gsh + 128; LAS float* egc = gsh + 192;
        LAS float* CW = (LAS float*)(F.lds + DNL_CW); asm volatile("" : "+v"(CW));
        __syncthreads();
        if (h != hcur) { hcur = h;
            for (int i = tid; i < 4 * 3 * 32; i += NTHR) { const int j = i / 96, s2 = (i / 32) % 3, c4 = i & 31;
                *(LAS f32x4*)(CW + (j * 3 + s2) * 128 + 4 * c4) = *(const f32x4*)(A.in[IN_CONVW] + (size_t)(layer * 4 + j) * 3072 + s2 * 1024 + h * 128 + 4 * c4); }
            __syncthreads(); }
        const int t = tid >> 3, sub = tid & 7, n = t0 + t;
        const int tsw = (((t >> 3) ^ sub) << 3) | (t & 7);
        float kn[16];
        {
            float a[3][16];
            {
            f32x2p a2[3][8];
#pragma unroll
            for (int s = 0; s < 3; ++s)
#pragma unroll
                for (int k = 0; k < 8; ++k) a2[s][k] = (f32x2p){0.f, 0.f};
            {
                unsigned km[4];
#pragma unroll
                for (int j = 0; j < 4; ++j) km[j] = (c * 64 + t - 3 + j) >= 0 ? 0xffffffffu : 0u;
#pragma unroll
                for (int j = 0; j < 4; ++j)
#pragma unroll
                    for (int s = 0; s < 3; ++s) { asm volatile("" ::: "memory");
                        const LAS float* cw = CW + (j * 3 + s) * 128 + 16 * sub; const u32x4 x0 = xr[j][s][0] & km[j], x1 = xr[j][s][1] & km[j];
                        const f32x4 w0 = *(const LAS f32x4*)cw, w1 = *(const LAS f32x4*)(cw + 4), w2 = *(const LAS f32x4*)(cw + 8), w3 = *(const LAS f32x4*)(cw + 12);
                        dn_pkfma(a2[s][0], (f32x2p){bflo(x0.x), bfhi(x0.x)}, __builtin_shufflevector(w0, w0, 0, 1)); dn_pkfma(a2[s][1], (f32x2p){bflo(x0.y), bfhi(x0.y)}, __builtin_shufflevector(w0, w0, 2, 3));
                        dn_pkfma(a2[s][2], (f32x2p){bflo(x0.z), bfhi(x0.z)}, __builtin_shufflevector(w1, w1, 0, 1)); dn_pkfma(a2[s][3], (f32x2p){bflo(x0.w), bfhi(x0.w)}, __builtin_shufflevector(w1, w1, 2, 3));
                        dn_pkfma(a2[s][4], (f32x2p){bflo(x1.x), bfhi(x1.x)}, __builtin_shufflevector(w2, w2, 0, 1)); dn_pkfma(a2[s][5], (f32x2p){bflo(x1.y), bfhi(x1.y)}, __builtin_shufflevector(w2, w2, 2, 3));
                        dn_pkfma(a2[s][6], (f32x2p){bflo(x1.z), bfhi(x1.z)}, __builtin_shufflevector(w3, w3, 0, 1)); dn_pkfma(a2[s][7], (f32x2p){bflo(x1.w), bfhi(x1.w)}, __builtin_shufflevector(w3, w3, 2, 3)); }
                asm volatile("" ::: "memory"); }
#pragma unroll
            for (int s = 0; s < 3; ++s)
#pragma unroll
                for (int k = 0; k < 16; ++k) a[s][k] = a2[s][k >> 1][k & 1];
            }
            const unsigned abcur = abw;
            DN_PREFETCH(uo + 1, tid);
            float sq = 0.f, sk = 0.f;
#pragma unroll
            for (int k = 0; k < 16; ++k) { a[0][k] = siluf(a[0][k]); a[1][k] = siluf(a[1][k]); a[2][k] = siluf(a[2][k]); sq += a[0][k] * a[0][k]; sk += a[1][k] * a[1][k]; }
            sq += __shfl_xor(sq, 1); sq += __shfl_xor(sq, 2); sq += __shfl_xor(sq, 4); sk += __shfl_xor(sk, 1); sk += __shfl_xor(sk, 2); sk += __shfl_xor(sk, 4);
            const float rq = rsqrtf(sq + EPS) * 0.08838834764831845f, rk = rsqrtf(sk + EPS);
            u32x4 qa, qb, ka, kb;
#pragma unroll
            for (int k = 0; k < 16; ++k) { a[0][k] *= rq; kn[k] = a[1][k] * rk; }
            qa.x = pk2(a[0][0], a[0][1]); qa.y = pk2(a[0][2], a[0][3]); qa.z = pk2(a[0][4], a[0][5]); qa.w = pk2(a[0][6], a[0][7]);
            qb.x = pk2(a[0][8], a[0][9]); qb.y = pk2(a[0][10], a[0][11]); qb.z = pk2(a[0][12], a[0][13]); qb.w = pk2(a[0][14], a[0][15]);
            ka.x = pk2(kn[0], kn[1]); ka.y = pk2(kn[2], kn[3]); ka.z = pk2(kn[4], kn[5]); ka.w = pk2(kn[6], kn[7]);
            kb.x = pk2(kn[8], kn[9]); kb.y = pk2(kn[10], kn[11]); kb.z = pk2(kn[12], kn[13]); kb.w = pk2(kn[14], kn[15]);
            *(LAS u32x4*)(QN + t * DN_RS + 16 * sub) = qa; *(LAS u32x4*)(QN + t * DN_RS + 16 * sub + 8) = qb;
            *(LAS u32x4*)(KN + t * DN_RS + 16 * sub) = ka; *(LAS u32x4*)(KN + t * DN_RS + 16 * sub + 8) = kb;
#pragma unroll
            for (int k = 0; k < 16; ++k) { KT[(16 * sub + k) * DN_TS + tsw] = (bf16)f2bf(kn[k]); VT[(16 * sub + k) * DN_TS + tsw] = (bf16)f2bf(a[2][k]); }
            if (sub == 0) { const float al = bflo(abcur), be = bfhi(abcur);
                gsh[t] = -expf(A.in[IN_ALOG][layer * 8 + h]) * softplusf_(al + A.in[IN_DTB][layer * 8 + h]); bsh[t] = sigmoidf_(be); }
        }
        __syncthreads();
        if (w == 0) { float v = gsh[lane];
#pragma unroll
            for (int o = 1; o < 64; o <<= 1) { const float nb = __shfl_up(v, o); if (lane >= o) v += nb; }
            gcs[lane] = v; egc[lane] = __expf(v);
            if (lane == 63) ((float*)(F.ws + WS_DNEG))[unit] = __expf(v); }
        __syncthreads();
        { const float sc = __expf(gcs[63] - gcs[t]);
#pragma unroll
          for (int k = 0; k < 16; ++k) KDT[(16 * sub + k) * DN_TS + tsw] = (bf16)f2bf(kn[k] * sc); }
        _Pragma("unroll 1") for (int rep3_ = 0; rep3_ < REP_DN3; ++rep3_)
        { const int mat = w >> 2, mt = w & 3; const LAS bf16* Am = mat ? QN : KN;
          bf16x8 af[4];
#pragma unroll
          for (int ks = 0; ks < 4; ++ks) af[ks] = *(const LAS bf16x8*)(Am + (16 * mt + r) * DN_RS + 32 * ks + 8 * q);
#pragma unroll
          for (int nt = 0; nt < 4; ++nt) { f32x4 d = (f32x4){0.f, 0.f, 0.f, 0.f};
#pragma unroll
              for (int ks = 0; ks < 4; ++ks) { const bf16x8 bfr = *(const LAS bf16x8*)(KN + (16 * nt + r) * DN_RS + 32 * ks + 8 * q); d = __builtin_amdgcn_mfma_f32_16x16x32_bf16(af[ks], bfr, d, 0, 0, 0); }
              const int j = 16 * nt + r; const float gj = gcs[j];
#pragma unroll
              for (int ii = 0; ii < 4; ++ii) { const int i = 16 * mt + 4 * q + ii; const float dec = (i >= j) ? __expf(gcs[i] - gj) : 0.f;
                  if (mat == 0) LM[i * DN_LS + j] = (i > j) ? bsh[i] * d[ii] * dec : 0.f; else AT[i * DN_TS + j] = (bf16)f2bf(d[ii] * dec); } } }
        __syncthreads();
        {
            const int col = tid >> 1, par = tid & 1, d = col & 127; const bool isw = col >= 128; LAS bf16* rowp = (isw ? KT : VT) + d * DN_TS + 4 * par; const int sd = d >> 4;
            f32x2p xp[16];
            _Pragma("unroll 1") for (int rep4_ = 0; rep4_ < REP_DN4; ++rep4_) {
#pragma unroll
            for (int g = 0; g < 8; ++g) { const u32x2 v = *(const LAS u32x2*)(rowp + 8 * (g ^ sd));
                const f32x4 bb = *(const LAS f32x4*)(bsh + 8 * g + 4 * par), ee = *(const LAS f32x4*)(egc + 8 * g + 4 * par);
                xp[2 * g] = (f32x2p){bflo(v.x) * bb[0] * (isw ? ee[0] : 1.0f), bfhi(v.x) * bb[1] * (isw ? ee[1] : 1.0f)};
                xp[2 * g + 1] = (f32x2p){bflo(v.y) * bb[2] * (isw ? ee[2] : 1.0f), bfhi(v.y) * bb[3] * (isw ? ee[3] : 1.0f)}; }
            DnSolveRow<63>::run(xp, LM + 4 * par, par);
            if (rep4_ == REP_DN4 - 1) {
#pragma unroll
            for (int g = 0; g < 8; ++g) { u32x2 v; v.x = pk2(xp[2 * g][0], xp[2 * g][1]); v.y = pk2(xp[2 * g + 1][0], xp[2 * g + 1][1]); *(LAS u32x2*)(rowp + 8 * (g ^ sd)) = v; } } }
        }
        __syncthreads();
        _Pragma("unroll 1") for (int rep5_ = 0; rep5_ < REP_DN5; ++rep5_)
        { const LAS bf16* UT = VT; const LAS bf16* WT = KT;
          bf16* gW = (bf16*)(F.ws + WS_DNW) + (size_t)unit * 16384; bf16* gN = (bf16*)(F.ws + WS_DNN) + (size_t)unit * 16384;
          bf16* gQ = (bf16*)(F.ws + WS_DNQ) + (size_t)unit * 8192; bf16* gO = (bf16*)(F.ws + WS_DNOL) + (size_t)unit * 8192;
          const int p2 = w >> 1, hh = w & 1;
          bf16x8 wf2[2][2], uf[2], kf[2];
#pragma unroll
          for (int ks = 0; ks < 2; ++ks) {
#pragma unroll
              for (int tl = 0; tl < 2; ++tl) wf2[tl][ks] = *(const LAS bf16x8*)(WT + (16 * (2 * p2 + tl) + r) * DN_TS + 8 * ((4 * ks + q) ^ (2 * p2 + tl)));
              uf[ks] = *(const LAS bf16x8*)(UT + (16 * w + r) * DN_TS + 8 * ((4 * ks + q) ^ w)); kf[ks] = *(const LAS bf16x8*)(KDT + (16 * w + r) * DN_TS + 8 * ((4 * ks + q) ^ w)); }
#pragma unroll
          for (int n4 = 0; n4 < 4; ++n4) { const int nt = 4 * hh + n4; f32x4 d0 = (f32x4){0.f, 0.f, 0.f, 0.f}, d1 = (f32x4){0.f, 0.f, 0.f, 0.f};
#pragma unroll
              for (int ks = 0; ks < 2; ++ks) { const bf16x8 bfr = *(const LAS bf16x8*)(KDT + (16 * nt + r) * DN_TS + 8 * ((4 * ks + q) ^ nt));
                  d0 = __builtin_amdgcn_mfma_f32_16x16x32_bf16(wf2[0][ks], bfr, d0, 0, 0, 0); d1 = __builtin_amdgcn_mfma_f32_16x16x32_bf16(wf2[1][ks], bfr, d1, 0, 0, 0); }
              u32x4 o; o.x = pk2(-d0[0], -d0[1]); o.y = pk2(-d0[2], -d0[3]); o.z = pk2(-d1[0], -d1[1]); o.w = pk2(-d1[2], -d1[3]);
              if (FAKE != 2) *(u32x4*)(gW + (size_t)(((nt * 4 + p2) * 64 + lane) * 8)) = o; }
#pragma unroll
          for (int nt = 0; nt < 8; ++nt) { f32x4 d = (f32x4){0.f, 0.f, 0.f, 0.f};
#pragma unroll
              for (int ks = 0; ks < 2; ++ks) { const bf16x8 bfr = *(const LAS bf16x8*)(UT + (16 * nt + r) * DN_TS + 8 * ((4 * ks + q) ^ nt)); d = __builtin_amdgcn_mfma_f32_16x16x32_bf16(kf[ks], bfr, d, 0, 0, 0); }
              u32x2 o; o.x = pk2(d[0], d[1]); o.y = pk2(d[2], d[3]); if (FAKE != 2) *(u32x2*)(gN + (size_t)(((nt * 8 + w) * 64 + lane) * 4)) = o; }
#pragma unroll
          for (int n2 = 0; n2 < 2; ++n2) { const int nt = 2 * hh + n2; f32x4 d0 = (f32x4){0.f, 0.f, 0.f, 0.f}, d1 = (f32x4){0.f, 0.f, 0.f, 0.f};
#pragma unroll
              for (int ks = 0; ks < 2; ++ks) { const bf16x8 bfr = *(const LAS bf16x8*)(AT + (16 * nt + r) * DN_TS + 32 * ks + 8 * q);
                  d0 = __builtin_amdgcn_mfma_f32_16x16x32_bf16(wf2[0][ks], bfr, d0, 0, 0, 0); d1 = __builtin_amdgcn_mfma_f32_16x16x32_bf16(wf2[1][ks], bfr, d1, 0, 0, 0); }
              const int tt = 16 * nt + r; const float eg = egc[tt]; const u32x2 qa = *(const LAS u32x2*)(QN + tt * DN_RS + 32 * p2 + 4 * q), qb = *(const LAS u32x2*)(QN + tt * DN_RS + 32 * p2 + 16 + 4 * q);
              u32x4 o; o.x = pk2(bflo(qa.x) * eg - d0[0], bfhi(qa.x) * eg - d0[1]); o.y = pk2(bflo(qa.y) * eg - d0[2], bfhi(qa.y) * eg - d0[3]);
              o.z = pk2(bflo(qb.x) * eg - d1[0], bfhi(qb.x) * eg - d1[1]); o.w = pk2(bflo(qb.y) * eg - d1[2], bfhi(qb.y) * eg - d1[3]);
              if (FAKE != 2) *(u32x4*)(gQ + (size_t)(((nt * 4 + p2) * 64 + lane) * 8)) = o; }
#pragma unroll
          for (int nt = 0; nt < 4; ++nt) { f32x4 e = (f32x4){0.f, 0.f, 0.f, 0.f};
#pragma unroll
              for (int ks = 0; ks < 2; ++ks) { const bf16x8 bfr = *(const LAS bf16x8*)(AT + (16 * nt + r) * DN_TS + 32 * ks + 8 * q); e = __builtin_amdgcn_mfma_f32_16x16x32_bf16(uf[ks], bfr, e, 0, 0, 0); }
              u32x2 p; p.x = pk2(e[0], e[1]); p.y = pk2(e[2], e[3]); if (FAKE != 2) *(u32x2*)(gO + (size_t)(((nt * 8 + w) * 64 + lane) * 4)) = p; }
        }
    }
}
constexpr int DN_PF = 8;
template <int MODE = 0> __device__ __forceinline__ void dn_scan_coop(const Args& A, const Frame& F, int tsk) {
    const int r = F.lane & 15, q = F.lane >> 4, w = F.wave, sl = (tsk >> 3) & 7, bh = 4 * (tsk & 7) + (tsk >> 6);
    LAS unsigned char* SF = F.lds;
    const float* egp = (const float*)(F.ws + WS_DNEG) + (size_t)bh * 64;
    const bf16* gW0 = (const bf16*)(F.ws + WS_DNW) + (size_t)bh * 64 * 16384 + (size_t)((w * 4) * 64 + F.lane) * 8;
    const bf16* gN0 = (const bf16*)(F.ws + WS_DNN) + (size_t)bh * 64 * 16384 + (size_t)((sl * 8 + w) * 64 + F.lane) * 4;
    unsigned char* gS1 = F.ws + WS_DNS + ((size_t)bh * 64 * 8 + sl) * 4096 + (size_t)(64 * (w & 3) + F.lane) * 16;
    f32x4 acc = (f32x4){0.f, 0.f, 0.f, 0.f};
    bf16x8 wf[DN_PF][4]; u32x2 nw[DN_PF];
    const float egv = egp[F.lane];
#pragma unroll
    for (int d = 0; d < DN_PF; ++d) {
#pragma unroll
        for (int ks = 0; ks < 4; ++ks) wf[d][ks] = *(const bf16x8*)(gW0 + (size_t)d * 16384 + 512 * ks);
        nw[d] = *(const u32x2*)(gN0 + (size_t)d * 16384); }
#ifdef SCAN_ROLLED
#pragma unroll 1
    for (int c0 = 0; c0 < NCHUNK; c0 += 2 * DN_PF) {
#pragma unroll
        for (int dd = 0; dd < 2 * DN_PF; ++dd) { const int d = dd % DN_PF, c = c0 + dd;
#else
#pragma unroll
    for (int c0 = 0; c0 < NCHUNK; c0 += DN_PF) {
#pragma unroll
        for (int d = 0; d < DN_PF; ++d) { const int c = c0 + d;
#endif
            u32x2 v; v.x = pk2(acc[0], acc[1]); v.y = pk2(acc[2], acc[3]);
            *(LAS u32x2*)(SF + ((c & 1) * 4 + (w >> 1)) * 1024 + F.lane * 16 + 8 * (w & 1)) = v;
            __syncthreads();
            bf16x8 sf[4];
#pragma unroll
            for (int ks = 0; ks < 4; ++ks) sf[ks] = *(const LAS bf16x8*)(SF + ((c & 1) * 4 + ks) * 1024 + F.lane * 16);
            if (MODE == 0 && w < 4) { const u32x4 sw = *(const LAS u32x4*)(SF + ((c & 1) * 4 + w) * 1024 + F.lane * 16); *(u32x4*)(gS1 + (size_t)c * 8 * 4096) = sw; }
            const float e = __builtin_bit_cast(float, __builtin_amdgcn_readlane(__builtin_bit_cast(int, egv), c));
            acc[0] = acc[0] * e + bflo(nw[d].x); acc[1] = acc[1] * e + bfhi(nw[d].x); acc[2] = acc[2] * e + bflo(nw[d].y); acc[3] = acc[3] * e + bfhi(nw[d].y);
#pragma unroll
            for (int ks = 0; ks < 4; ++ks) acc = __builtin_amdgcn_mfma_f32_16x16x32_bf16(wf[d][ks], sf[ks], acc, 0, 0, 0);
            { const int cn = MODE == 1 ? 0 : (c + DN_PF < NCHUNK ? c + DN_PF : NCHUNK - 1);
#pragma unroll
                for (int ks = 0; ks < 4; ++ks) wf[d][ks] = *(const bf16x8*)(gW0 + (size_t)cn * 16384 + 512 * ks);
                nw[d] = *(const u32x2*)(gN0 + (size_t)cn * 16384); }
        }
    }
}
__device__ __forceinline__ void dn_out(const Args& A, const Frame& F, int layer) {
    const bf16* proj = (const bf16*)(F.ws + WS_PROJ); bf16* mc = (bf16*)(F.ws + WS_MIXCAT);
    const int r = F.lane & 15, q = F.lane >> 4;
    for (int task = F.gw; task < NBATCH * 8 * NCHUNK * 4; task += F.ngw) {
        const int unit = task >> 2, mt = task & 3, c = unit & 63, h = (unit >> 6) & 7, b = unit >> 9, tok = b * SEQ + c * 64 + 16 * mt + r;
        const bf16* gQ = (const bf16*)(F.ws + WS_DNQ) + (size_t)unit * 8192 + (size_t)((mt * 4) * 64 + F.lane) * 8; const bf16* gO = (const bf16*)(F.ws + WS_DNOL) + (size_t)unit * 8192 + (size_t)((mt * 8) * 64 + F.lane) * 4;
        const u32x4* gS = (const u32x4*)(F.ws + WS_DNS) + (size_t)unit * 8 * 256 + F.lane;
        bf16x8 qf[4];
#pragma unroll
        for (int ks = 0; ks < 4; ++ks) qf[ks] = *(const bf16x8*)(gQ + 512 * ks);
        u32x4 sv[32]; u32x2 ow[8], gwv[8];
#pragma unroll
        for (int sl = 0; sl < 8; ++sl) ow[sl] = *(const u32x2*)(gO + 256 * sl);
#pragma unroll
        for (int i = 0; i < 32; ++i) sv[i] = gS[i * 64];
#pragma unroll
        for (int sl = 0; sl < 8; ++sl) gwv[sl] = *(const u32x2*)(proj + (size_t)tok * DINP + C_GATE + h * 128 + 16 * sl + 4 * q);
        f32x4 o[8]; float ss = 0.f;
#pragma unroll
        for (int sl = 0; sl < 8; ++sl) { o[sl] = (f32x4){bflo(ow[sl].x), bfhi(ow[sl].x), bflo(ow[sl].y), bfhi(ow[sl].y)};
#pragma unroll
            for (int ks = 0; ks < 4; ++ks) o[sl] = __builtin_amdgcn_mfma_f32_16x16x32_bf16(__builtin_bit_cast(bf16x8, sv[sl * 4 + ks]), qf[ks], o[sl], 0, 0, 0);
            ss += (o[sl][0] * o[sl][0] + o[sl][1] * o[sl][1]) + (o[sl][2] * o[sl][2] + o[sl][3] * o[sl][3]); }
        ss += __shfl_xor(ss, 16); ss += __shfl_xor(ss, 32);
        const float rs = rsqrtf(ss * (1.0f / 128.0f) + EPS);
#pragma unroll
        for (int sl = 0; sl < 8; ++sl) { const f32x4 an = *(const f32x4*)(A.in[IN_ANORM] + layer * 128 + 16 * sl + 4 * q); const u32x2 gw = gwv[sl];
            u32x2 w; w.x = pk2(o[sl][0] * rs * an[0] * siluf(bflo(gw.x)), o[sl][1] * rs * an[1] * siluf(bfhi(gw.x))); w.y = pk2(o[sl][2] * rs * an[2] * siluf(bflo(gw.y)), o[sl][3] * rs * an[3] * siluf(bfhi(gw.y)));
            *(u32x2*)(mc + (size_t)tok * DM + h * 128 + 16 * sl + 4 * q) = w; }
    }
}
#ifndef MULTI_LAUNCH
#define MULTI_LAUNCH 1
#endif
#ifndef NAIVE_DN
#define NAIVE_DN 1
#endif
#ifndef NAIVE_SWA
#define NAIVE_SWA 1
#endif
#ifndef NAIVE_S5
#define NAIVE_S5 1
#endif

#ifndef USE_NAIVE_DN
#define USE_NAIVE_DN 1
#endif
#ifndef USE_NAIVE_SWA
#define USE_NAIVE_SWA 1
#endif
#ifndef USE_NAIVE_S5
#define USE_NAIVE_S5 1
#endif

__device__ __forceinline__ void site_gemm_store(LAS unsigned char* lds, const bf16* Amat, const bf16* Bt, int nM, int nN, int K, const int* tile_e, bf16* O, int ldc, int G, int bid) {
    pg8::Gemm g{Amat, Bt, nM * 256, nN * 256, K}; pg8::ExpertOrder S; S.init(nM, nN, G, bid, tile_e);
    pg8::EpiStore E{O, ldc}; pg8::gemm_phase<pg8::EpiStore, pg8::ExpertOrder, true, true>(lds, g, S, E);
}
__device__ __forceinline__ void site_gemm_swiglu(LAS unsigned char* lds, const bf16* Amat, const bf16* Bt, int nM, int nN, int K, const int* tile_e, bf16* O, int ldc, int G, int bid) {
    pg8::Gemm g{Amat, Bt, nM * 256, nN * 256, K}; pg8::ExpertOrder S; S.init(nM, nN, G, bid, tile_e);
    pg8::EpiSwiGLU E{O, ldc}; pg8::gemm_phase<pg8::EpiSwiGLU, pg8::ExpertOrder, true, true>(lds, g, S, E);
}
__device__ __forceinline__ void site_gemm_glu(LAS unsigned char* lds, const bf16* Amat, const bf16* Bt, int nM, int nN, int K, bf16* O, const float* bias, int ldc, int G, int bid) {
    pg8::Gemm g{Amat, Bt, nM * 256, nN * 256, K}; pg8::ExpertOrder S; S.init(nM, nN, G, bid, nullptr);
    pg8::EpiGLU E{O, Amat, bias, ldc}; pg8::gemm_phase<pg8::EpiGLU, pg8::ExpertOrder, true, true>(lds, g, S, E);
}
__device__ __forceinline__ void site_gemm_swiglu8(LAS unsigned char* lds, const bf16* Amat, const bf16* Bt, int nM, int nN, int Kh, const int* tile_e, unsigned char* O, int ldc, int G, int bid) {
    pg8::Gemm g{Amat, Bt, nM * 256, nN * 256, Kh}; pg8::ExpertOrder S; S.init(nM, nN, G, bid, tile_e);
    pg8::EpiSwiGLU8 E{O, ldc, 1.0f / (F8_SA * F8_SW), F8_SH}; pg8::gemm_phase<pg8::EpiSwiGLU8, pg8::ExpertOrder, true, true, true>(lds, g, S, E);
}
__device__ __forceinline__ void site_gemm_store8(LAS unsigned char* lds, const bf16* Amat, const bf16* Bt, int nM, int nN, int Kh, const int* tile_e, bf16* O, int ldc, int G, int bid) {
    pg8::Gemm g{Amat, Bt, nM * 256, nN * 256, Kh}; pg8::ExpertOrder S; S.init(nM, nN, G, bid, tile_e);
    pg8::EpiStoreScaled E{O, ldc, 1.0f / (F8_SH * F8_SW)}; pg8::gemm_phase<pg8::EpiStoreScaled, pg8::ExpertOrder, true, true, true>(lds, g, S, E);
}
__device__ __forceinline__ void site_gemm_store8_split(LAS unsigned char* lds, const bf16* Amat, const bf16* Bt, int nM, int nN, int Kh, const int* tile_e, bf16* O, float* Pp, int ldc, int G, int bid) {
    pg8::Gemm g{Amat, Bt, nM * 256, nN * 256, Kh}; pg8::ExpertOrderSplit S; S.init(nM, nN, YP_NF, G, bid, tile_e);
    pg8::EpiStoreScaledSplit E{O, Pp, ldc, 1.0f / (F8_SH * F8_SW), YP_NF, YP_SLICE}; pg8::gemm_phase<pg8::EpiStoreScaledSplit, pg8::ExpertOrderSplit, true, true, true>(lds, g, S, E);
}
__device__ __forceinline__ void site_gemm_swiglu_i8(LAS unsigned char* lds, const bf16* Amat, const bf16* Bt, int nM, int nN, int Kh, bf16* O, int ldc, const float* rowscale, const unsigned* wmax, int G, int bid) {
    pg8::Gemm g{Amat, Bt, nM * 256, nN * 256, Kh}; pg8::ExpertOrder S; S.init(nM, nN, G, bid, nullptr);
    pg8::EpiSwiGLUi8 E{O, ldc, rowscale, wmax}; pg8::gemm_phase<pg8::EpiSwiGLUi8, pg8::ExpertOrder, true, true, false, true>(lds, g, S, E);
}
__device__ __forceinline__ void site_gemm_store_i8(LAS unsigned char* lds, const bf16* Amat, const bf16* Bt, int nM, int nN, int Kh, bf16* O, int ldc, const float* rowscale, const unsigned* wmax, int G, int bid) {
    pg8::Gemm g{Amat, Bt, nM * 256, nN * 256, Kh}; pg8::ExpertOrder S; S.init(nM, nN, G, bid, nullptr);
    pg8::EpiStoreI8 E{O, ldc, rowscale, wmax}; pg8::gemm_phase<pg8::EpiStoreI8, pg8::ExpertOrder, true, true, false, true>(lds, g, S, E);
}
extern __shared__ __attribute__((aligned(16))) unsigned char lds_raw[];
__device__ __forceinline__ void fresh(const Args& A, Frame& F) {
    long zoff = 0; asm volatile("" : "+s"(zoff));
    unsigned char* ws = A.ws + zoff; float* out = A.out + zoff;
    int tid = threadIdx.x; asm volatile("" : "+v"(tid));
    F.lds = (LAS unsigned char*)lds_raw;
    F.tid = tid; F.lane = tid & 63; F.wave = __builtin_amdgcn_readfirstlane(tid >> 6); F.G = gridDim.x; F.bid = blockIdx.x;
    F.gw = F.bid * NWAVES + F.wave; F.ngw = F.G * NWAVES; F.gt = F.bid * NTHR + tid; F.ngt = F.G * NTHR;
    F.out = out; F.ws = ws;
}
__device__ __forceinline__ void grid_bar(const Args& A) {
    long zoff = 0; asm volatile("" : "+s"(zoff));
    unsigned char* ws = A.ws + zoff;
    XcdBarrier b; b.bar = (unsigned*)(ws + WS_CTL) + CW_BAR; b.x = xb_xcc_id(); b.st = (volatile LAS unsigned*)((LAS unsigned char*)lds_raw + LDS_MISC) + 8;
#ifdef REP_BAR
    xcd_barrier(b);
#endif
    xcd_barrier(b);
}
#define PH_BEGIN Frame F; fresh(A, F); const Args& P = A; (void)P;
#define WSP(off) ((bf16*)(F.ws + (off)))
#ifndef REP_P0W
#define REP_P0W 1
#endif
#ifndef REP_P0T
#define REP_P0T 1
#endif
#ifndef REP_P0N
#define REP_P0N 1
#endif
__device__ __forceinline__ void ph_p0(const Args& A) {
    _Pragma("unroll 1") for (int rep_ = 0; rep_ < REP_P0W; ++rep_) { PH_BEGIN p0_weights(P, F); }
    _Pragma("unroll 1") for (int rep_ = 0; rep_ < REP_P0T; ++rep_) { PH_BEGIN p0_s5tab(P, F); }
    _Pragma("unroll 1") for (int rep_ = 0; rep_ < REP_P0N; ++rep_) { PH_BEGIN rp_norm1(P, F, P.in[IN_X], P.in[IN_LNG], WSP(WS_HN)); }
    if (USE_I8) { PH_BEGIN __syncthreads(); p0_i8_strips(P, F); } }
template <int layer> __device__ __forceinline__ void ph_win(const Args& A) { PH_BEGIN
    if (USE_I8_WIN) site_gemm_store_i8(F.lds, WSP(WS_HN), WSP(WS_WIN + layer * WIN_BYTES), NTOK / 256, DINP / 256, DM / 2, WSP(WS_PROJ), DINP, (const float*)(F.ws + WS_MISC) + MI_ROWSC, (const unsigned*)(F.ws + WS_CTL) + CW_COLMAX + layer * DINP, F.G, F.bid);
    else site_gemm_store(F.lds, WSP(WS_HN), WSP(WS_WIN + layer * WIN_BYTES), NTOK / 256, DINP / 256, DM, nullptr, WSP(WS_PROJ), DINP, F.G, F.bid); }
template <int layer> __device__ __forceinline__ void ph_dnprep_n(const Args& A) { PH_BEGIN dn_prep_naive(P, F, layer); }
template <int layer> __device__ __forceinline__ void ph_dnscan_n(const Args& A) { PH_BEGIN if (F.wave == 0 && F.bid < 128) dn_scan_naive(P, F, F.bid); }
template <int layer> __device__ __forceinline__ void ph_dnfin_n(const Args& A) { PH_BEGIN dn_finalize_naive(P, F, layer); }
template <int layer> __device__ __forceinline__ void ph_swa_n(const Args& A) { PH_BEGIN swa_naive(P, F, layer); }
template <int layer> __device__ __forceinline__ void ph_s5scan_n(const Args& A) { PH_BEGIN if (F.wave == 0 && F.bid >= 128) s5_scan_naive(P, F, layer, F.bid - 128); }
template <int layer> __device__ __forceinline__ void ph_s5out_n(const Args& A) { PH_BEGIN s5_out_naive(P, F, layer); }
template <int layer> __device__ __forceinline__ void ph_dnprep(const Args& A) { PH_BEGIN dn_chunk_prep(P, F, layer); }
#ifdef DN_FAKE
template <int layer> __device__ __forceinline__ void ph_dnprep_fake(const Args& A) { PH_BEGIN dn_chunk_prep<DN_FAKE>(P, F, layer); }
#endif
template <int layer> __device__ __forceinline__ void ph_dnscan(const Args& A) { PH_BEGIN for (int tsk = F.bid; tsk < 256; tsk += F.G) { __syncthreads(); dn_scan_coop(P, F, tsk); } }
template <int layer> __device__ __forceinline__ void ph_dnout(const Args& A) { PH_BEGIN dn_out(P, F, layer); }
template <int layer> __device__ __forceinline__ void ph_swa(const Args& A) { PH_BEGIN swa_mfma(P, F, layer); }
template <int layer> __device__ __forceinline__ void ph_s5a(const Args& A) { PH_BEGIN s5_chunk<false>(P, F, layer, F.gw, F.ngw); }
template <int layer> __device__ __forceinline__ void ph_s5b(const Args& A) { PH_BEGIN s5_chunk<true>(P, F, layer, F.gw, F.ngw); }
#ifndef REP_SCAN
#define REP_SCAN 1
#endif
#ifndef REP_S5B
#define REP_S5B 1
#endif
template <int layer> __device__ __forceinline__ void ph_scan_s5b(const Args& A) {
#ifdef SCAN_PROBE
    { PH_BEGIN for (int tsk = F.bid; tsk < 256; tsk += F.G) { __syncthreads(); dn_scan_coop<SCAN_PROBE>(P, F, tsk); } __syncthreads(); }
#endif
    _Pragma("unroll 1") for (int rep_ = 0; rep_ < REP_SCAN; ++rep_) { PH_BEGIN for (int tsk = F.bid; tsk < 256; tsk += F.G) { __syncthreads(); dn_scan_coop(P, F, tsk); } __syncthreads(); }
    _Pragma("unroll 1") for (int rep_ = 0; rep_ < REP_S5B; ++rep_) { PH_BEGIN s5_chunk<true>(P, F, layer, F.gw, F.ngw); } }
template <int layer> __device__ __forceinline__ void ph_glu(const Args& A) { PH_BEGIN site_gemm_glu(F.lds, WSP(WS_Z), WSP(WS_WGLU + layer * WGLU_BYTES), NTOK / 256, 2, 512, WSP(WS_GLU), P.in[IN_BGLU] + layer * 512, 512, F.G, F.bid); }
template <int layer> __device__ __forceinline__ void ph_bcfin(const Args& A) { PH_BEGIN bc_finalize(P, F, layer, NAIVE_SWA != 0, true); }
template <int layer> __device__ __forceinline__ void ph_wout(const Args& A) { PH_BEGIN site_gemm_store(F.lds, WSP(WS_MIXCAT), WSP(WS_WOUT + layer * WOUT_BYTES), NTOK / 256, DM / 256, DM, nullptr, WSP(WS_MIXOUT), DM, F.G, F.bid); }
template <int layer> __device__ __forceinline__ void ph_postmix(const Args& A) { PH_BEGIN const float* gains = P.in[IN_LNG] + (size_t)layer * 4 * DM;
    rp_post_mixer(P, F, layer == 0 ? P.in[IN_X] : F.out, WSP(WS_MIXOUT), gains + DM, gains + 2 * DM, WSP(WS_HN), (layer & 1) != 0, P.in[IN_WR]); }
__device__ __forceinline__ void ph_dispatch(const Args& A) { PH_BEGIN moe_dispatch(P, F, WSP(WS_HN)); }
template <int layer> __device__ __forceinline__ void ph_gateup(const Args& A) { PH_BEGIN const int* misc = (const int*)(F.ws + WS_MISC);
    if (layer & 1) { if (USE_FP8) site_gemm_swiglu8(F.lds, WSP(WS_XG), WSP(WS_MGU), misc[MI_NTILES], 2 * DFF / 256, DM / 2, misc + MI_TILEE, F.ws + WS_HID, DFF, F.G, F.bid);
                     else site_gemm_swiglu(F.lds, WSP(WS_XG), WSP(WS_MGU), misc[MI_NTILES], 2 * DFF / 256, DM, misc + MI_TILEE, WSP(WS_HID), DFF, F.G, F.bid); }
    else { if (USE_FP8 && FP8_E0 == 0) site_gemm_swiglu8(F.lds, WSP(WS_HN), WSP(WS_FGU), NTOK / 256, 2 * DFF / 256, DM / 2, nullptr, F.ws + WS_HID, DFF, F.G, F.bid);
           else if (USE_I8) site_gemm_swiglu_i8(F.lds, WSP(WS_HN), WSP(WS_FGU), NTOK / 256, 2 * DFF / 256, DM / 2, WSP(WS_HID), DFF, (const float*)(F.ws + WS_MISC) + MI_ROWSC, (const unsigned*)(F.ws + WS_CTL) + CW_COLMAX + 2 * DINP, F.G, F.bid);
           else site_gemm_swiglu(F.lds, WSP(WS_HN), WSP(WS_FGU), NTOK / 256, 2 * DFF / 256, DM, nullptr, WSP(WS_HID), DFF, F.G, F.bid); } }
template <int layer> __device__ __forceinline__ void ph_down(const Args& A) { PH_BEGIN const int* misc = (const int*)(F.ws + WS_MISC);
    if (layer & 1) { if (USE_FP8) site_gemm_store8_split(F.lds, WSP(WS_HID), WSP(WS_MD), misc[MI_NTILES], DM / 256, DFF / 2, misc + MI_TILEE, WSP(WS_YG), (float*)(F.ws + WS_YP), DM, F.G, F.bid);
                     else site_gemm_store(F.lds, WSP(WS_HID), WSP(WS_MD), misc[MI_NTILES], DM / 256, DFF, misc + MI_TILEE, WSP(WS_YG), DM, F.G, F.bid); }
    else { if (USE_FP8 && FP8_E0 == 0) site_gemm_store8(F.lds, WSP(WS_HID), WSP(WS_FD), NTOK / 256, DM / 256, DFF / 2, nullptr, WSP(WS_YG), DM, F.G, F.bid);
           else site_gemm_store(F.lds, WSP(WS_HID), WSP(WS_FD), NTOK / 256, DM / 256, DFF, nullptr, WSP(WS_YG), DM, F.G, F.bid); } }
template <int layer> __device__ __forceinline__ void ph_postffn(const Args& A) { PH_BEGIN const float* gains = P.in[IN_LNG] + (size_t)layer * 4 * DM;
    rp_post_ffn(P, F, WSP(WS_YG), (layer & 1) != 0, gains + 3 * DM, layer == 0 ? P.in[IN_LNG] + 4 * DM : nullptr, WSP(WS_HN)); }

#if MULTI_LAUNCH
typedef void (*PhaseFn)(const Args&);
template <PhaseFn FN> __global__ void __launch_bounds__(NTHR, 2) kph(Args A) { FN(A); }
template <PhaseFn FN> static void launch_phase(const Args& a, int grid, hipStream_t stream) {
    static bool attr = false; if (!attr) { (void)hipFuncSetAttribute((const void*)kph<FN>, hipFuncAttributeMaxDynamicSharedMemorySize, LDS_BYTES); attr = true; }
    hipLaunchKernelGGL((kph<FN>), dim3(grid), dim3(NTHR), LDS_BYTES, stream, a);
}
template <int layer> static void launch_layer(const Args& a, int grid, hipStream_t stream) {
    launch_phase<ph_win<layer>>(a, grid, stream);
#if NAIVE_DN
    launch_phase<ph_dnprep_n<layer>>(a, grid, stream);
#else
    launch_phase<ph_dnprep<layer>>(a, grid, stream);
#endif
#if NAIVE_SWA
    launch_phase<ph_swa_n<layer>>(a, grid, stream);
#else
    launch_phase<ph_swa<layer>>(a, grid, stream);
#endif
#if NAIVE_S5
    launch_phase<ph_s5scan_n<layer>>(a, grid, stream); launch_phase<ph_s5out_n<layer>>(a, grid, stream);
#else
    launch_phase<ph_s5a<layer>>(a, grid, stream); launch_phase<ph_s5b<layer>>(a, grid, stream);
#endif
#if NAIVE_DN
    launch_phase<ph_dnscan_n<layer>>(a, grid, stream); launch_phase<ph_dnfin_n<layer>>(a, grid, stream);
#else
    launch_phase<ph_dnscan<layer>>(a, grid, stream); launch_phase<ph_dnout<layer>>(a, grid, stream);
#endif
    launch_phase<ph_glu<layer>>(a, grid, stream); launch_phase<ph_bcfin<layer>>(a, grid, stream); launch_phase<ph_wout<layer>>(a, grid, stream); launch_phase<ph_postmix<layer>>(a, grid, stream);
    if (layer & 1) launch_phase<ph_dispatch>(a, grid, stream);
    launch_phase<ph_gateup<layer>>(a, grid, stream); launch_phase<ph_down<layer>>(a, grid, stream); launch_phase<ph_postffn<layer>>(a, grid, stream);
}
static void launch_all(const Args& a, int grid, hipStream_t stream) { launch_phase<ph_p0>(a, grid, stream); launch_layer<0>(a, grid, stream); launch_layer<1>(a, grid, stream); }
#define MAIN_KERNEL kph<ph_p0>
#else
#ifndef REP_P0
#define REP_P0 1
#endif
#ifndef REP_PROJ
#define REP_PROJ 1
#endif
#ifndef REP_MIX
#define REP_MIX 1
#endif
#ifndef REP_FFN
#define REP_FFN 1
#endif
#ifndef REP_MIX1A
#define REP_MIX1A 1
#endif
#ifndef REP_MIX1B
#define REP_MIX1B 1
#endif
#ifndef REP_MIX1C
#define REP_MIX1C 1
#endif
#ifndef REP_MIX2
#define REP_MIX2 1
#endif
#ifndef REP_MIX3
#define REP_MIX3 1
#endif
#define REPEAT(n, stmt) do { _Pragma("unroll 1") for (int rep_ = 0; rep_ < (n); ++rep_) { stmt; } } while (0)
template <int layer> __device__ __forceinline__ void layer_body(const Args& A) {
    REPEAT(REP_PROJ, ph_win<layer>(A)); grid_bar(A);
#ifdef DN_FAKE
    ph_dnprep_fake<layer>(A);
#endif
    REPEAT(REP_MIX1A, ph_dnprep<layer>(A)); REPEAT(REP_MIX1B, ph_swa<layer>(A)); REPEAT(REP_MIX1C, ph_s5a<layer>(A)); grid_bar(A);
    REPEAT(REP_MIX2, ph_scan_s5b<layer>(A)); grid_bar(A);
    REPEAT(REP_MIX3, ph_glu<layer>(A); ph_dnout<layer>(A)); grid_bar(A); REPEAT(REP_MIX, ph_bcfin<layer>(A)); grid_bar(A); REPEAT(REP_PROJ, ph_wout<layer>(A)); grid_bar(A); ph_postmix<layer>(A); grid_bar(A);
    if (layer & 1) { ph_dispatch(A); grid_bar(A); }
    REPEAT(REP_FFN, ph_gateup<layer>(A)); grid_bar(A); REPEAT(REP_FFN, ph_down<layer>(A)); grid_bar(A); ph_postffn<layer>(A);
    if (layer == 0) grid_bar(A);
}
__global__ void __launch_bounds__(NTHR, 2) fwd_kernel(Args A) {
    { volatile LAS unsigned* MISC = (volatile LAS unsigned*)((LAS unsigned char*)lds_raw + LDS_MISC);
      if (threadIdx.x < 32) MISC[threadIdx.x] = 0u;
      __syncthreads();
      (void)xcd_barrier_post((unsigned*)(A.ws + WS_CTL) + CW_BAR, MISC + 8); }
    REPEAT(REP_P0, ph_p0(A)); grid_bar(A);
    layer_body<0>(A);
    layer_body<1>(A);
}
static void launch_all(const Args& a, int grid, hipStream_t stream) {
    static bool attr = false; if (!attr) { (void)hipFuncSetAttribute((const void*)fwd_kernel, hipFuncAttributeMaxDynamicSharedMemorySize, LDS_BYTES); attr = true; }
    hipLaunchKernelGGL(fwd_kernel, dim3(grid), dim3(NTHR), LDS_BYTES, stream, a);
}
#endif

extern "C" void kernel_launch(void* const* d_in, const int* in_sizes, int n_in, void* d_out, int out_size, void* d_ws, size_t ws_size, hipStream_t stream) {
    static int grid = 0;
    if (grid == 0) {
        if (n_in != 28 || out_size != NTOK * DM || ws_size < WS_END) { fprintf(stderr, "kernel_launch: unexpected problem: n_in %d out %d ws %zu (need %zu)\n", n_in, out_size, ws_size, (size_t)WS_END); grid = -1; return; }
        int dev = 0, cus = 0;
        if (hipGetDevice(&dev) != hipSuccess || hipDeviceGetAttribute(&cus, hipDeviceAttributeMultiprocessorCount, dev) != hipSuccess) { grid = -1; return; }
        grid = cus;
    }
    if (grid < 0) return;
    (void)hipMemsetAsync((char*)d_ws + WS_CTL, 0, CTL_BYTES, stream);
    Args a{};
    for (int i = 0; i < 28; ++i) a.in[i] = (const float*)d_in[i];
    a.out = (float*)d_out; a.ws = (unsigned char*)d_ws;
    launch_all(a, grid, stream);
}
```
